# Optimizing an MI355X kernel written in HIP

```python
import math
import jax, jax.numpy as jnp
from jax import lax
import numpy as np

D_MODEL = 1024
BATCH = 32
SEQ = 2048
DEPTH = 1

HEAD_DIM = 64
DIFF_HEADS = D_MODEL // (4 * HEAD_DIM)
DIFF_QK_WIDTH = DIFF_HEADS * 2 * HEAD_DIM
DIFF_V_DIM = 2 * HEAD_DIM
DIFF_WIDTH = DIFF_HEADS * DIFF_V_DIM
SWA_Q_HEADS = D_MODEL // (2 * HEAD_DIM)
SWA_KV_HEADS = 2
SWA_GROUP = SWA_Q_HEADS // SWA_KV_HEADS
SWA_WIDTH = SWA_Q_HEADS * HEAD_DIM
SWA_KV_WIDTH = SWA_KV_HEADS * HEAD_DIM
WINDOW = 128
BLOCK = 128
MIX_WIDTH = DIFF_WIDTH + SWA_WIDTH
IN_WIDTH = 2 * DIFF_QK_WIDTH + DIFF_WIDTH + SWA_WIDTH + 2 * SWA_KV_WIDTH
SPLIT_POINTS = [DIFF_QK_WIDTH,
                2 * DIFF_QK_WIDTH,
                2 * DIFF_QK_WIDTH + DIFF_WIDTH,
                2 * DIFF_QK_WIDTH + DIFF_WIDTH + SWA_WIDTH,
                2 * DIFF_QK_WIDTH + DIFF_WIDTH + SWA_WIDTH + SWA_KV_WIDTH]
ROPE_THETA = 10000.0
N_GROUPS = 4
EXPERTS_PER_GROUP = 4
N_EXPERTS = N_GROUPS * EXPERTS_PER_GROUP
TOP_K = 2
D_EXPERT = 512
EPS = 1e-6

kernel_name = "hymba_diffattn_swa_sink_hmoe_adaln"


def rmsnorm(x, g):
    xf = x.astype(jnp.float32)
    y = xf * lax.rsqrt(jnp.mean(xf * xf, axis=-1, keepdims=True) + EPS)
    return (y * g.astype(jnp.float32)).astype(x.dtype)


def rope_tables(seq, dtype):
    inv = ROPE_THETA ** (-jnp.arange(0, HEAD_DIM, 2, dtype=jnp.float32) / HEAD_DIM)
    ang = jnp.arange(seq, dtype=jnp.float32)[:, None] * inv[None, :]
    ang = jnp.concatenate([ang, ang], axis=-1)
    return jnp.cos(ang).astype(dtype), jnp.sin(ang).astype(dtype)


def apply_rope(x, cos, sin):
    shape = (1, x.shape[1]) + (1,) * (x.ndim - 3) + (HEAD_DIM,)
    cs, sn = cos.reshape(shape), sin.reshape(shape)
    x1, x2 = jnp.split(x, 2, axis=-1)
    return x * cs + jnp.concatenate([-x2, x1], axis=-1) * sn


def diff_attention(q, k, v, lam):
    B, S, H = q.shape[:3]
    nb = S // BLOCK
    scale = HEAD_DIM ** -0.5
    qb = q.reshape(B, nb, BLOCK, H, 2, HEAD_DIM).transpose(1, 0, 2, 3, 4, 5)
    kpos = jnp.arange(S)

    def one_block(args):
        qblk, n = args
        s = jnp.einsum('bqhmd,bkhmd->bhmqk', qblk, k).astype(jnp.float32) * scale
        qpos = n * BLOCK + jnp.arange(BLOCK)
        causal = kpos[None, :] <= qpos[:, None]
        p = jax.nn.softmax(jnp.where(causal, s, -jnp.inf), axis=-1)
        a = (p[:, :, 0] - lam * p[:, :, 1]).astype(v.dtype)
        return jnp.einsum('bhqk,bkhe->bqhe', a, v)

    out = lax.map(one_block, (qb, jnp.arange(nb)))
    return out.transpose(1, 0, 2, 3, 4).reshape(B, S, H, DIFF_V_DIM)


def swa_attention(q, k, v, sinks):
    B, S = q.shape[:2]
    nb = S // BLOCK
    scale = HEAD_DIM ** -0.5
    qb = q.reshape(B, nb, BLOCK, SWA_KV_HEADS, SWA_GROUP, HEAD_DIM)

    def band(t):
        tb = t.reshape(B, nb, BLOCK, SWA_KV_HEADS, HEAD_DIM)
        prev = jnp.concatenate([jnp.zeros_like(tb[:, :1]), tb[:, :-1]], axis=1)
        return jnp.concatenate([prev, tb], axis=2)

    kb, vb = band(k), band(v)
    s = jnp.einsum('bnqhgd,bnkhd->bnhgqk', qb, kb).astype(jnp.float32) * scale
    i = jnp.arange(BLOCK)[:, None]
    j = jnp.arange(2 * BLOCK)[None, :]
    dist = i + BLOCK - j
    in_window = (dist >= 0) & (dist < WINDOW)
    blk = jnp.arange(nb)[:, None, None]
    mask = in_window[None] & ((blk > 0) | (j >= BLOCK)[None])
    s = jnp.where(mask[None, :, None, None], s, -jnp.inf)
    sink = sinks.astype(jnp.float32).reshape(SWA_KV_HEADS, SWA_GROUP)[None, None, :, :, None, None]
    s_full = jnp.concatenate([s, jnp.broadcast_to(sink, s.shape[:-1] + (1,))], axis=-1)
    p = jax.nn.softmax(s_full, axis=-1)[..., :-1].astype(v.dtype)
    out = jnp.einsum('bnhgqk,bnkhd->bnqhgd', p, vb)
    return out.reshape(B, S, SWA_WIDTH)


def hierarchical_moe(h, w_rg, b_rg, w_re, b_re, w_gate, w_up, w_down):
    B, S, _ = h.shape
    grp_logits = (h @ w_rg).astype(jnp.float32) + b_rg.astype(jnp.float32)
    grp_prob = jax.nn.softmax(grp_logits, axis=-1)
    grp_p, grp_idx = lax.top_k(grp_prob, 1)
    exp_logits = ((h @ w_re).astype(jnp.float32) + b_re.astype(jnp.float32)).reshape(
        B, S, N_GROUPS, EXPERTS_PER_GROUP)
    in_grp = jnp.take_along_axis(exp_logits, grp_idx[..., None], axis=2)[:, :, 0]
    exp_prob = jax.nn.softmax(in_grp, axis=-1)
    top_p, top_i = lax.top_k(exp_prob, TOP_K)
    top_p = top_p / jnp.sum(top_p, axis=-1, keepdims=True)
    within = jnp.sum(jax.nn.one_hot(top_i, EXPERTS_PER_GROUP, dtype=jnp.float32) * top_p[..., None], axis=-2)
    grp_w = jax.nn.one_hot(grp_idx[..., 0], N_GROUPS, dtype=jnp.float32) * grp_p
    combine = (grp_w[..., :, None] * within[..., None, :]).reshape(B, S, N_EXPERTS).astype(h.dtype)
    y = jnp.zeros_like(h)
    for e in range(N_EXPERTS):
        a = jax.nn.silu(h @ w_gate[e]) * (h @ w_up[e])
        y = y + combine[..., e:e + 1] * (a @ w_down[e])
    return y


def setup_inputs(seed: int = 0) -> dict:
    key = jax.random.key(seed)
    ks = jax.random.split(key, 20)
    f32 = jnp.float32
    D = D_MODEL
    nrm = lambda k, shape, scale: jax.random.normal(k, shape, f32) * scale
    return {
        "x": nrm(ks[0], (BATCH, SEQ, D), 1.0),
        "c": nrm(ks[1], (BATCH, D), 1.0),
        "w_ada": nrm(ks[2], (DEPTH, D, 6 * D), D ** -0.5),
        "b_ada": nrm(ks[3], (DEPTH, 6 * D), 0.02),
        "g_mix": 1.0 + nrm(ks[4], (DEPTH, D), 0.02),
        "w_in": nrm(ks[5], (DEPTH, D, IN_WIDTH), D ** -0.5),
        "diff_lambda": nrm(ks[6], (DEPTH, 4, HEAD_DIM), 0.1),
        "g_diff_sub": 1.0 + nrm(ks[7], (DEPTH, DIFF_V_DIM), 0.02),
        "swa_sinks": nrm(ks[8], (DEPTH, SWA_Q_HEADS), 0.5),
        "w_out": nrm(ks[9], (DEPTH, MIX_WIDTH, D), MIX_WIDTH ** -0.5),
        "g_ffn": 1.0 + nrm(ks[10], (DEPTH, D), 0.02),
        "w_route_group": nrm(ks[11], (DEPTH, D, N_GROUPS), D ** -0.5),
        "b_route_group": nrm(ks[12], (DEPTH, N_GROUPS), 0.01),
        "w_route_expert": nrm(ks[13], (DEPTH, D, N_EXPERTS), D ** -0.5),
        "b_route_expert": nrm(ks[14], (DEPTH, N_EXPERTS), 0.01),
        "w_gate": nrm(ks[15], (DEPTH, N_EXPERTS, D, D_EXPERT), D ** -0.5),
        "w_up": nrm(ks[16], (DEPTH, N_EXPERTS, D, D_EXPERT), D ** -0.5),
        "w_down": nrm(ks[17], (DEPTH, N_EXPERTS, D_EXPERT, D), D_EXPERT ** -0.5),
        "g_final": 1.0 + nrm(ks[18], (D,), 0.02),
    }


def reference(x, c, w_ada, b_ada, g_mix, w_in, diff_lambda, g_diff_sub, swa_sinks, w_out,
              g_ffn, w_route_group, b_route_group, w_route_expert, b_route_expert,
              w_gate, w_up, w_down, g_final):
    B, S, _ = x.shape
    cos, sin = rope_tables(S, x.dtype)
    c_act = jax.nn.silu(c)
    for l in range(DEPTH):
        mod = c_act @ w_ada[l] + b_ada[l]
        sh1, sc1, gt1, sh2, sc2, gt2 = [m[:, None, :] for m in jnp.split(mod, 6, axis=-1)]

        h = rmsnorm(x, g_mix[l]) * (1.0 + sc1) + sh1
        proj = h @ w_in[l]
        dq, dk, dv, sq, sk, sv = jnp.split(proj, SPLIT_POINTS, axis=-1)

        lambda_init = 0.8 - 0.6 * math.exp(-0.3 * l)
        lam_p = diff_lambda[l].astype(jnp.float32)
        lam = jnp.exp(jnp.sum(lam_p[0] * lam_p[1])) - jnp.exp(jnp.sum(lam_p[2] * lam_p[3])) + lambda_init
        dq = apply_rope(dq.reshape(B, S, DIFF_HEADS, 2, HEAD_DIM), cos, sin)
        dk = apply_rope(dk.reshape(B, S, DIFF_HEADS, 2, HEAD_DIM), cos, sin)
        dv = dv.reshape(B, S, DIFF_HEADS, DIFF_V_DIM)
        o_diff = diff_attention(dq, dk, dv, lam)
        o_diff = (rmsnorm(o_diff, g_diff_sub[l]) * (1.0 - lambda_init)).reshape(B, S, DIFF_WIDTH)

        sq = apply_rope(sq.reshape(B, S, SWA_Q_HEADS, HEAD_DIM), cos, sin)
        sk = apply_rope(sk.reshape(B, S, SWA_KV_HEADS, HEAD_DIM), cos, sin)
        sv = sv.reshape(B, S, SWA_KV_HEADS, HEAD_DIM)
        o_swa = swa_attention(sq, sk, sv, swa_sinks[l])

        mix = jnp.concatenate([o_diff, o_swa], axis=-1) @ w_out[l]
        x = x + gt1 * mix

        h2 = rmsnorm(x, g_ffn[l]) * (1.0 + sc2) + sh2
        y = hierarchical_moe(h2, w_route_group[l], b_route_group[l], w_route_expert[l],
                             b_route_expert[l], w_gate[l], w_up[l], w_down[l])
        x = x + gt2 * y
    return rmsnorm(x, g_final)
```

```cpp
#include <hip/hip_runtime.h>
#include <cstdio>
#include <cstdint>
namespace pg8 {
#define PG8_LAS __attribute__((address_space(3)))
typedef unsigned short bf16_t;
typedef short bf16x8 __attribute__((ext_vector_type(8)));
typedef float f32x4 __attribute__((ext_vector_type(4)));
typedef unsigned u32x4 __attribute__((ext_vector_type(4)));
constexpr int BM = 256, BK = 64, HALF = 128, HTB = HALF * BK * 2  , STAGE_BYTES = 8 * HTB, NXCD = 8, WGM = 8;

__host__ __device__ __forceinline__ int lds_byte(int r, int c) { const int st = (r >> 4) * 2 + (c >> 5), rr = r & 15, cc = c & 31, ob = rr * 64 + cc * 2; return st * 1024 + (ob ^ (((ob >> 9) & 1) << 5)); }
__host__ __device__ __forceinline__ void stage_rc(int b, int& R, int& C) { const int st = b / 1024, sb = b % 1024, swz = sb ^ (((sb >> 9) & 1) << 5); R = (st >> 1) * 16 + swz / 64; C = (st & 1) * 32 + (swz % 64) / 2; }
__host__ __device__ __forceinline__ int perm32(int rho) { const int n = rho >> 4, i = rho & 15; return 8 * (i >> 2) + 4 * n + (i & 3); }

struct Unit { int pm, pn, e; };
struct Gemm { const bf16_t* A; const bf16_t* Bt; int M, N, K; size_t bstride; };

struct StaticOrder {
    int nM, nN, nwg, G, c;
    __host__ __device__ void init(int M, int N, int G_, int c_) { nM = M / BM; nN = N / BM; nwg = nM * nN; G = G_; c = c_; }
    __host__ __device__ bool next(int i, Unit& u) const {
        const long L = (long)i * G + c; if (L >= nwg) return false;
        int wgid = (int)L; { const int q = nwg / NXCD, r = nwg % NXCD, xcd = wgid % NXCD, off = wgid / NXCD; wgid = (xcd < r ? xcd * (q + 1) : r * (q + 1) + (xcd - r) * q) + off; }
        const int nig = WGM * nN, gid = wgid / nig, fm = gid * WGM, gsz = (nM - fm) < WGM ? (nM - fm) : WGM;
        u.pm = fm + ((wgid % nig) % gsz); u.pn = (wgid % nig) / gsz; u.e = 0; return true;
    }
    __device__ __forceinline__ void a_ready(const Unit&) const {}
    __device__ __forceinline__ void done(const Unit&) const {}
};

__device__ __forceinline__ unsigned cvt_pk_bf16(float lo, float hi) { unsigned r; asm volatile("v_cvt_pk_bf16_f32 %0, %1, %2" : "=v"(r) : "v"(lo), "v"(hi)); return r; }
typedef float f32x2 __attribute__((ext_vector_type(2)));

struct EpiPlain {
    static constexpr bool PERM = true, AFTER_DRAIN = false;
    bf16_t* O; int ldc;
    __device__ __forceinline__ void operator()(const f32x4 (&acc)[2][2][4][2], const Unit& u, int wr, int wc, int fr, int fq) const {
        const int row0 = u.pm * BM + wr * 64 + fr; const int col0 = u.pn * BM + wc * 32 + 8 * fq;
#pragma unroll
        for (int ai = 0; ai < 2; ++ai)
#pragma unroll
            for (int m = 0; m < 4; ++m) { bf16_t* rowp = O + (size_t)(row0 + ai * HALF + m * 16) * ldc + col0;
#pragma unroll
                for (int bj = 0; bj < 2; ++bj) { const f32x4 v0 = acc[ai][bj][m][0], v1 = acc[ai][bj][m][1];
                    u32x4 w; w.x = cvt_pk_bf16(v0[0], v0[1]); w.y = cvt_pk_bf16(v0[2], v0[3]); w.z = cvt_pk_bf16(v1[0], v1[1]); w.w = cvt_pk_bf16(v1[2], v1[3]);
                    *(u32x4*)(rowp + bj * HALF) = w; } }
    }
};
struct MoeOrder {
    int nN, G, c, R; const PG8_LAS int* tstart;
    __device__ __forceinline__ bool next(int i, Unit& u) const {
        const long L = (long)i * G + c; if (L >= (long)R * nN) return false;
        const int rt = (int)(L / nN); u.pn = (int)(L % nN); u.pm = rt; int e = 0;
#pragma unroll
        for (int k = 1; k < 16; ++k) e += (rt >= tstart[k]) ? 1 : 0;
        u.e = __builtin_amdgcn_readfirstlane(e); return true;
    }
    __device__ __forceinline__ void a_ready(const Unit&) const {}
    __device__ __forceinline__ void done(const Unit&) const {}
};
template <class Epi, class Sched, bool ALIGN_EPI = false, bool SP2 = false>
__device__ __forceinline__ void gemm_phase(PG8_LAS unsigned char* lds, const Gemm g, const Sched& S, const Epi& E) {
    const int tid = threadIdx.x, wid = __builtin_amdgcn_readfirstlane(tid >> 6), lane = tid & 63, wr = wid >> 2, wc = wid & 3, fr = lane & 15, fq = lane >> 4;
    const int K = g.K, nt = K / BK;
    unsigned voffA[2], voffB[2];
#pragma unroll
    for (int i = 0; i < 2; ++i) { int R, C; stage_rc(tid * 16 + i * 8192, R, C); const int Rb = Epi::PERM ? ((R & ~31) + perm32(R & 31)) : R;
        voffA[i] = (unsigned)(R * K + C) * 2u; voffB[i] = (unsigned)(Rb * K + C) * 2u; }
    const size_t kstep = (size_t)(BK * 2);
    const size_t hstep = (size_t)HALF * K * 2;
    const size_t tstep = 2 * hstep;
    const unsigned ldsw = (unsigned)wid * 1024u;
    const int aoff = lds_byte(wr * 64 + fr, fq * 8), boff = lds_byte(wc * 32 + fr, fq * 8);
#define PG8_SA(b, h) (((b) * 2 + (h)) * HTB)
#define PG8_SB(b, h) ((4 + (b) * 2 + (h)) * HTB)
#define PG8_STAGE(bufoff, gbase, voff) do { _Pragma("unroll") for (int _i = 0; _i < 2; ++_i) \
        __builtin_amdgcn_global_load_lds((const unsigned*)((const char*)(gbase) + (voff)[_i]), (PG8_LAS unsigned*)(lds + (bufoff) + ldsw + _i * 8192), 16, 0, 0); } while (0)
#define PG8_LDA(dst, b, h) do { _Pragma("unroll") for (int m = 0; m < 4; ++m) _Pragma("unroll") for (int k = 0; k < 2; ++k) dst[m][k] = *(const PG8_LAS bf16x8*)(lds + PG8_SA(b, h) + aoff + m * 2048 + k * 1024); } while (0)
#define PG8_LDB(dst, b, h) do { _Pragma("unroll") for (int n = 0; n < 2; ++n) _Pragma("unroll") for (int k = 0; k < 2; ++k) dst[n][k] = *(const PG8_LAS bf16x8*)(lds + PG8_SB(b, h) + boff + n * 2048 + k * 1024); } while (0)
#define PG8_MMA(ai, bj, At, Bt) do { __builtin_amdgcn_s_setprio(1); _Pragma("unroll") for (int m = 0; m < 4; ++m) _Pragma("unroll") for (int n = 0; n < 2; ++n) _Pragma("unroll") for (int k = 0; k < 2; ++k) \
        acc[ai][bj][m][n] = __builtin_amdgcn_mfma_f32_16x16x32_bf16(Bt[n][k], At[m][k], acc[ai][bj][m][n], 0, 0, 0); __builtin_amdgcn_s_setprio(0); } while (0)
#define PG8_WAIT_V(n) asm volatile("s_waitcnt vmcnt(" #n ")" ::: "memory")
#define PG8_WAIT_L(n) asm volatile("s_waitcnt lgkmcnt(" #n ")" ::: "memory")
#define PG8_BAR __builtin_amdgcn_s_barrier()
#define PG8_SCHED __builtin_amdgcn_sched_barrier(0)
    Unit cur, nxt; int ui = 0;
    if (!S.next(0, cur)) return;
    f32x4 acc[2][2][4][2];
#pragma unroll
    for (int a = 0; a < 2; ++a)
#pragma unroll
        for (int b = 0; b < 2; ++b)
#pragma unroll
            for (int m = 0; m < 4; ++m)
#pragma unroll
                for (int n = 0; n < 2; ++n) acc[a][b][m][n] = (f32x4){0.f, 0.f, 0.f, 0.f};
    bf16x8 At[4][2], B0[2][2], B1[2][2];
    const char* cA = (const char*)g.A + (size_t)cur.pm * tstep; const char* cB = (const char*)g.Bt + (size_t)cur.e * g.bstride + (size_t)cur.pn * tstep;
    S.a_ready(cur);
    if constexpr (SP2) {
        PG8_STAGE(PG8_SB(0, 0), cB, voffB); PG8_STAGE(PG8_SB(0, 1), cB + hstep, voffB); PG8_STAGE(PG8_SA(0, 0), cA, voffA); PG8_STAGE(PG8_SA(0, 1), cA + hstep, voffA);
        if (wr == 1) PG8_BAR;
        PG8_WAIT_V(2); PG8_BAR;
        PG8_STAGE(PG8_SB(1, 0), cB + kstep, voffB); PG8_STAGE(PG8_SA(1, 0), cA + kstep, voffA); PG8_STAGE(PG8_SB(1, 1), cB + hstep + kstep, voffB);
        PG8_WAIT_V(6); PG8_BAR;
    } else {
        PG8_STAGE(PG8_SB(0, 0), cB, voffB); PG8_STAGE(PG8_SA(0, 0), cA, voffA); PG8_STAGE(PG8_SB(0, 1), cB + hstep, voffB); PG8_STAGE(PG8_SA(0, 1), cA + hstep, voffA);
        if (wr == 1) PG8_BAR;
        PG8_WAIT_V(4); PG8_BAR;
        PG8_STAGE(PG8_SB(1, 0), cB + kstep, voffB); PG8_STAGE(PG8_SA(1, 0), cA + kstep, voffA); PG8_STAGE(PG8_SB(1, 1), cB + hstep + kstep, voffB);
        PG8_WAIT_V(6); PG8_BAR;
    }
    for (;;) {
        const bool has_next = S.next(ui + 1, nxt);
        const char* nA = has_next ? (const char*)g.A + (size_t)nxt.pm * tstep : cA; const char* nB = has_next ? (const char*)g.Bt + (size_t)nxt.e * g.bstride + (size_t)nxt.pn * tstep : cB;
        for (int t = 0; t < nt; t += 2) {
            const bool last = (t == nt - 2);
            const char* a1 = cA + (size_t)(t + 1) * kstep;
            const char* a2 = last ? nA : cA + (size_t)(t + 2) * kstep; const char* b2 = last ? nB : cB + (size_t)(t + 2) * kstep;
            const char* a3 = a2 + kstep; const char* b3 = b2 + kstep;
            if (last && has_next) S.a_ready(nxt);
            if constexpr (SP2) {
            PG8_LDB(B0, 0, 0); PG8_LDB(B1, 0, 1); PG8_SCHED; PG8_LDA(At, 0, 0); PG8_STAGE(PG8_SA(1, 1), a1 + hstep, voffA);
            PG8_WAIT_V(8); PG8_WAIT_L(0); PG8_BAR; PG8_MMA(0, 0, At, B0); PG8_MMA(0, 1, At, B1); PG8_BAR; PG8_SCHED;
            PG8_LDA(At, 0, 1); PG8_STAGE(PG8_SB(0, 0), b2, voffB); PG8_STAGE(PG8_SB(0, 1), b2 + hstep, voffB); PG8_STAGE(PG8_SA(0, 0), a2, voffA);
            PG8_WAIT_V(8); PG8_WAIT_L(0); PG8_BAR; PG8_MMA(1, 0, At, B0); PG8_MMA(1, 1, At, B1); PG8_BAR; PG8_SCHED;
            PG8_LDB(B0, 1, 0); PG8_LDB(B1, 1, 1); PG8_SCHED; PG8_LDA(At, 1, 0); PG8_STAGE(PG8_SA(0, 1), a2 + hstep, voffA);
            PG8_WAIT_V(8); PG8_WAIT_L(0); PG8_BAR; PG8_MMA(0, 0, At, B0); PG8_MMA(0, 1, At, B1); PG8_BAR; PG8_SCHED;
            PG8_LDA(At, 1, 1); PG8_STAGE(PG8_SB(1, 0), b3, voffB); PG8_STAGE(PG8_SB(1, 1), b3 + hstep, voffB); PG8_STAGE(PG8_SA(1, 0), a3, voffA);
            PG8_WAIT_V(8); PG8_WAIT_L(0); PG8_BAR; PG8_MMA(1, 0, At, B0); PG8_MMA(1, 1, At, B1); PG8_BAR; PG8_SCHED;
            } else {
            PG8_LDB(B0, 0, 0); PG8_SCHED; PG8_LDA(At, 0, 0); PG8_STAGE(PG8_SA(1, 1), a1 + hstep, voffA);
            PG8_WAIT_L(8); PG8_BAR; PG8_WAIT_L(0); PG8_MMA(0, 0, At, B0); PG8_BAR; PG8_SCHED;
            PG8_LDB(B1, 0, 1); PG8_STAGE(PG8_SB(0, 0), b2, voffB);
            PG8_BAR; PG8_WAIT_L(0); PG8_MMA(0, 1, At, B1); PG8_BAR;
            PG8_LDA(At, 0, 1); PG8_STAGE(PG8_SA(0, 0), a2, voffA);
            PG8_BAR; PG8_WAIT_L(0); PG8_MMA(1, 0, At, B0); PG8_BAR; PG8_SCHED;
            PG8_STAGE(PG8_SB(0, 1), b2 + hstep, voffB);
            PG8_WAIT_V(6); PG8_BAR; PG8_MMA(1, 1, At, B1); PG8_BAR;
            PG8_LDB(B0, 1, 0); PG8_SCHED; PG8_LDA(At, 1, 0); PG8_STAGE(PG8_SA(0, 1), a2 + hstep, voffA);
            PG8_WAIT_L(8); PG8_BAR; PG8_WAIT_L(0); PG8_MMA(0, 0, At, B0); PG8_BAR; PG8_SCHED;
            PG8_LDB(B1, 1, 1); PG8_STAGE(PG8_SB(1, 0), b3, voffB);
            PG8_BAR; PG8_WAIT_L(0); PG8_MMA(0, 1, At, B1); PG8_BAR;
            PG8_LDA(At, 1, 1); PG8_STAGE(PG8_SA(1, 0), a3, voffA);
            PG8_BAR; PG8_WAIT_L(0); PG8_MMA(1, 0, At, B0); PG8_BAR; PG8_SCHED;
            PG8_STAGE(PG8_SB(1, 1), b3 + hstep, voffB);
            PG8_WAIT_V(6); PG8_BAR; PG8_MMA(1, 1, At, B1); PG8_BAR;
            }
        }
        if constexpr (ALIGN_EPI) { if (wr == 0) PG8_BAR; }
        if constexpr (!Epi::AFTER_DRAIN) { E(acc, cur, wr, wc, fr, fq); S.done(cur); }
        if (!has_next) break;
#pragma unroll
        for (int a = 0; a < 2; ++a)
#pragma unroll
            for (int b = 0; b < 2; ++b)
#pragma unroll
                for (int m = 0; m < 4; ++m)
#pragma unroll
                    for (int n = 0; n < 2; ++n) acc[a][b][m][n] = (f32x4){0.f, 0.f, 0.f, 0.f};
        cur = nxt; cA = nA; cB = nB; ++ui;
        if constexpr (ALIGN_EPI) { if (wr == 1) PG8_BAR; }
    }
    PG8_WAIT_V(0);
    if constexpr (!ALIGN_EPI) { if (wr == 0) PG8_BAR; }
    PG8_BAR;
    if constexpr (Epi::AFTER_DRAIN) { E.fused(acc, cur, wr, wc, fr, fq, lds, wid, lane); S.done(cur); }
#undef PG8_SA
#undef PG8_SB
#undef PG8_STAGE
#undef PG8_LDA
#undef PG8_LDB
#undef PG8_MMA
#undef PG8_WAIT_V
#undef PG8_WAIT_L
#undef PG8_BAR
#undef PG8_SCHED
}
}

constexpr int NWAVES = 8;
#ifndef MK_ONE_LAUNCH
#define MK_ONE_LAUNCH 0
#endif
constexpr int N_PHASES = 13;

constexpr int BATCH = 32, SEQ = 2048, D = 1024, T = BATCH * SEQ;
constexpr int NQKV = 2304, C_DQ = 0, C_DK = 512, C_DV = 1024, C_SQ = 1536, C_SK = 2048, C_SV = 2176;
constexpr int NEXP = 16, DEXP = 512;
constexpr int SORT_ROWS = 2 * T + NEXP * 256;
constexpr float EPS = 1e-6f;

constexpr size_t MiB = 1u << 20;
constexpr size_t WS_CTL = 0, CTL_ZERO_BYTES = 1 * MiB;
constexpr size_t WS_MOD = 1 * MiB;
constexpr size_t WS_ROPE = 2 * MiB;
constexpr size_t WS_TOK = 3 * MiB;
constexpr size_t WS_LIST = 5 * MiB;
constexpr size_t WS_WIN = 10 * MiB;
constexpr size_t WS_WO = 15 * MiB;
constexpr size_t WS_WGU = 17 * MiB;
constexpr size_t WS_WD = 49 * MiB;
constexpr size_t WS_ACT = 66 * MiB;
constexpr size_t WS_QKV = 194 * MiB;
constexpr size_t WS_GU = 482 * MiB;
constexpr size_t WS_ACTM = 746 * MiB;
constexpr size_t WS_END = 878 * MiB;
static_assert(WS_QKV + (size_t)T * NQKV * 2 <= WS_GU && WS_QKV + (size_t)SORT_ROWS * 1024 * 2 <= WS_GU && WS_GU + (size_t)SORT_ROWS * 1024 * 2 <= WS_ACTM && WS_GU + (size_t)T * 1024 * 4 <= WS_ACTM && WS_ACTM + (size_t)SORT_ROWS * 512 * 2 <= WS_END, "ws map");
constexpr int CW_CNT = 64;
constexpr int CW_BAR = 4096;

constexpr int RING_BYTES = 131072;
constexpr int MISC_OFF = RING_BYTES + 320;
constexpr int LDS_BYTES = 147456;

#define GAS __attribute__((address_space(1)))
#define LAS __attribute__((address_space(3)))
typedef unsigned short bf16;
typedef unsigned v4u __attribute__((ext_vector_type(4)));
typedef unsigned v2u __attribute__((ext_vector_type(2)));
typedef float f32x4 __attribute__((ext_vector_type(4)));
#define RLX_AGENT __ATOMIC_RELAXED, __HIP_MEMORY_SCOPE_AGENT
#define LDS_WAIT() asm volatile("s_waitcnt lgkmcnt(0)" ::: "memory")
__device__ __forceinline__ unsigned f2bf(float f) { unsigned u = __builtin_bit_cast(unsigned, f); return (u + 0x7fffu + ((u >> 16) & 1u)) >> 16; }
__device__ __forceinline__ unsigned pk2(float lo, float hi) { return f2bf(lo) | (f2bf(hi) << 16); }
__device__ __forceinline__ float bflo(unsigned w) { return __builtin_bit_cast(float, w << 16); }
__device__ __forceinline__ float bfhi(unsigned w) { return __builtin_bit_cast(float, w & 0xffff0000u); }
__device__ __forceinline__ float wave_sum(float v) {
#pragma unroll
    for (int o = 1; o < 64; o <<= 1) v += __shfl_xor(v, o);
    return v;
}

#define XB_TMO      128
#define XB_XCNT(j)  (256  + 64 * (j))
#define XB_XSUB(j)  (1280 + 64 * (j))
#define XB_XGEN(j)  (2304 + 64 * (j))
#define XB_TOP      3328
#define XB_TOPGEN   3392
#define XCD_BAR_WORDS 3456
#define XB_SPIN_CAP (1u << 18)

__device__ __forceinline__ unsigned xb_ld(unsigned* p)              { return __hip_atomic_load(p, __ATOMIC_RELAXED, __HIP_MEMORY_SCOPE_AGENT); }
__device__ __forceinline__ unsigned xb_add(unsigned* p, unsigned v) { return __hip_atomic_fetch_add(p, v, __ATOMIC_RELAXED, __HIP_MEMORY_SCOPE_AGENT); }
__device__ __forceinline__ unsigned xb_xcc_id() { return (unsigned)__builtin_amdgcn_s_getreg((3 << 11) | 20) & 0xFu; }
#define XB_SPIN(cond, bar) do { unsigned _sp = 0; while (cond) { __builtin_amdgcn_s_sleep(1); \
    if ((++_sp & 255u) == 0u) { if (xb_ld(&(bar)[XB_TMO])) break; if (_sp > XB_SPIN_CAP) { atomicAdd(&(bar)[XB_TMO], 1u); break; } } } } while (0)

struct XcdBarrier {
    unsigned* bar; unsigned x;
    volatile LAS unsigned* st;
};

__device__ __forceinline__ XcdBarrier xcd_barrier_post(unsigned* bar, volatile LAS unsigned* st) {
    XcdBarrier b; b.bar = bar; b.x = xb_xcc_id(); b.st = st;
    if (threadIdx.x == 0) (void)xb_add(&bar[XB_XCNT(b.x)], 1u);
    return b;
}
__device__ __forceinline__ void xcd_barrier_complete(unsigned* bar, unsigned x, unsigned& nloc, unsigned& nx) {
    const unsigned G = gridDim.x * gridDim.y * gridDim.z;
    unsigned sum, cnt, mine, sp = 0u;
    for (;;) {
        sum = 0u; cnt = 0u; mine = 0u;
#pragma unroll
        for (unsigned j = 0; j < 16; ++j) { const unsigned c = xb_ld(&bar[XB_XCNT(j)]); sum += c; cnt += (c > 0u) ? 1u : 0u; mine = (j == x) ? c : mine; }
        if (sum == G) break;
        __builtin_amdgcn_s_sleep(1);
        if ((++sp & 255u) == 0u) { if (xb_ld(&bar[XB_TMO])) break; if (sp > XB_SPIN_CAP) { atomicAdd(&bar[XB_TMO], 1u); break; } }
    }
    nloc = mine > 0u ? mine : 1u; nx = cnt > 0u ? cnt : 1u;
}

__device__ __forceinline__ void xcd_barrier(const XcdBarrier& b) {
    asm volatile("s_waitcnt vmcnt(0)" ::: "memory");
    __syncthreads();
    if (threadIdx.x == 0) {
        unsigned* bar = b.bar;
        __builtin_amdgcn_s_waitcnt(0);
        unsigned nloc = b.st[0], nx = b.st[1];
        if (nloc == 0u) { xcd_barrier_complete(bar, b.x, nloc, nx); b.st[0] = nloc; b.st[1] = nx; }
        const unsigned old = xb_add(&bar[XB_XSUB(b.x)], 1u);
        const unsigned gen = old / nloc;
        if (old + 1u == (gen + 1u) * nloc) {
            __builtin_amdgcn_fence(__ATOMIC_RELEASE, "agent");
            asm volatile("s_waitcnt vmcnt(0)" ::: "memory");
            const unsigned og = xb_add(&bar[XB_TOP], 1u);
            const unsigned tg = og / nx;
            if (og + 1u == (tg + 1u) * nx) xb_add(&bar[XB_TOPGEN], 1u);
            else XB_SPIN(xb_ld(&bar[XB_TOPGEN]) == tg, bar);
            __builtin_amdgcn_fence(__ATOMIC_ACQUIRE, "agent");
            xb_add(&bar[XB_XGEN(b.x)], 1u);
            asm volatile("s_waitcnt vmcnt(0)" ::: "memory");
        } else {
            XB_SPIN(xb_ld(&bar[XB_XGEN(b.x)]) == gen, bar);
            __builtin_amdgcn_fence(__ATOMIC_ACQUIRE, "agent");
            asm volatile("s_waitcnt vmcnt(0)" ::: "memory");
        }
    }
    __syncthreads();
}


struct Frame {
    LAS unsigned char* lds;
    unsigned* ctl;
    int tid, lane, wave, G, bid;
    const float *x, *c, *w_ada, *b_ada, *g_mix, *w_in, *diff_lambda, *g_diff_sub, *swa_sinks, *w_out, *g_ffn, *w_rg, *b_rg, *w_re, *b_re, *w_gate, *w_up, *w_down, *g_final;
    float* out; unsigned char* ws;
    float* mod; float* rope;
    int *tok_e, *tok_r0, *tok_r1; float *tok_w0, *tok_w1; int* list;
    bf16 *WinT, *WoT, *WguT, *WdT, *ACT, *QKV, *MIX, *HS, *Y, *GU, *ACTM; float* DIFFO;
};

__device__ __forceinline__ void p0_transpose_item(const float* W, int K, int N, bf16* WT, int row_off, LAS float* scr, int item, int lane) {
    const int nblk = N / 32, kb = item / nblk, nb = item % nblk, k0 = 64 * kb, n0 = 32 * nb;
#pragma unroll 8
    for (int i = 0; i < 32; ++i) { const int kk = 2 * i + (lane >> 5); scr[kk * 33 + (lane & 31)] = W[(size_t)(k0 + kk) * N + n0 + (lane & 31)]; }
    LDS_WAIT(); asm volatile("" ::: "memory");
    const int c = lane & 7;
#pragma unroll
    for (int j = 0; j < 4; ++j) { const int n = (lane >> 3) + 8 * j; const LAS float* s = scr + (8 * c) * 33 + n;
        v4u o; o.x = pk2(s[0 * 33], s[1 * 33]); o.y = pk2(s[2 * 33], s[3 * 33]); o.z = pk2(s[4 * 33], s[5 * 33]); o.w = pk2(s[6 * 33], s[7 * 33]);
        *(v4u*)(WT + (size_t)(row_off + n0 + n) * K + k0 + 8 * c) = o; }
    LDS_WAIT(); asm volatile("" ::: "memory");
}

__device__ __forceinline__ void ph_prologue(Frame& F) {
    const int gw = F.bid * NWAVES + F.wave, NGW = F.G * NWAVES;
    if (F.bid < 96) {
        const int j0 = F.bid * 64, k0 = F.wave * 128;
        LAS float* ca = (LAS float*)(F.lds + F.wave * 16384);
        for (int i = F.lane; i < 4096; i += 64) { const int kk = i >> 5, b = i & 31; const float v = F.c[b * 1024 + k0 + kk]; ca[kk * 32 + b] = v / (1.f + __expf(-v)); }
        LDS_WAIT(); asm volatile("" ::: "memory");
        float acc[32];
#pragma unroll
        for (int b = 0; b < 32; ++b) acc[b] = 0.f;
        for (int kk = 0; kk < 128; ++kk) {
            const float w = F.w_ada[(size_t)(k0 + kk) * 6144 + j0 + F.lane];
#pragma unroll
            for (int b4 = 0; b4 < 8; ++b4) { const f32x4 cv = *(const LAS f32x4*)(ca + kk * 32 + b4 * 4);
                acc[b4 * 4 + 0] += cv.x * w; acc[b4 * 4 + 1] += cv.y * w; acc[b4 * 4 + 2] += cv.z * w; acc[b4 * 4 + 3] += cv.w * w; }
        }
        __syncthreads();
        LAS float* red = (LAS float*)F.lds;
#pragma unroll
        for (int b = 0; b < 32; ++b) red[(F.wave * 32 + b) * 64 + F.lane] = acc[b];
        __syncthreads();
        for (int o = F.tid; o < 2048; o += NWAVES * 64) { const int b = o >> 6, jj = o & 63; float s = 0.f;
#pragma unroll
            for (int w = 0; w < 8; ++w) s += red[(w * 32 + b) * 64 + jj];
            F.mod[b * 6144 + j0 + jj] = s + F.b_ada[j0 + jj]; }
        __syncthreads();
    }
    for (int i = F.bid * NWAVES * 64 + F.tid; i < SEQ * 32; i += F.G * NWAVES * 64) {
        const int pos = i >> 5, f = i & 31; const float inv = exp2f(-(float)f * (13.287712379549449f / 32.f)); const float ang = (float)pos * inv;
        F.rope[i] = cosf(ang); F.rope[SEQ * 32 + i] = sinf(ang); }
    LAS float* scr = (LAS float*)(F.lds + F.wave * 16384);
    constexpr int I_IN = 16 * 72, I_O = 16 * 32, I_G = 16 * 16 * 16, I_D = 16 * 8 * 32;
    constexpr int NITEMS = I_IN + I_O + 2 * I_G + I_D;
    for (int it = gw; it < NITEMS; it += NGW) {
        int r = it;
        if (r < I_IN) { p0_transpose_item(F.w_in, 1024, NQKV, F.WinT, 0, scr, r, F.lane); continue; } r -= I_IN;
        if (r < I_O) { p0_transpose_item(F.w_out, 1024, 1024, F.WoT, 0, scr, r, F.lane); continue; } r -= I_O;
        if (r < I_G) { const int e = r >> 8; p0_transpose_item(F.w_gate + (size_t)e * 1024 * 512, 1024, 512, F.WguT + (size_t)e * 1024 * 1024, 0, scr, r & 255, F.lane); continue; } r -= I_G;
        if (r < I_G) { const int e = r >> 8; p0_transpose_item(F.w_up + (size_t)e * 1024 * 512, 1024, 512, F.WguT + (size_t)e * 1024 * 1024, 512, scr, r & 255, F.lane); continue; } r -= I_G;
        { const int e = r >> 8; p0_transpose_item(F.w_down + (size_t)e * 512 * 1024, 512, 1024, F.WdT + (size_t)e * 1024 * 512, 0, scr, r & 255, F.lane); }
    }
}

__device__ __forceinline__ void ph_norm1(Frame& F) {
    const int gw = F.bid * NWAVES + F.wave, NGW = F.G * NWAVES;
    for (int m = gw; m < T; m += NGW) {
        const int b = m >> 11; const f32x4* xr = (const f32x4*)(F.x + (size_t)m * D) + F.lane;
        f32x4 v[4]; float s = 0.f;
#pragma unroll
        for (int j = 0; j < 4; ++j) { v[j] = xr[64 * j]; s += (v[j].x * v[j].x + v[j].y * v[j].y) + (v[j].z * v[j].z + v[j].w * v[j].w); }
        const float rstd = 1.f / sqrtf(wave_sum(s) * (1.f / D) + EPS);
        const float* mb = F.mod + b * 6144;
        unsigned long long* o8 = (unsigned long long*)(F.ACT + (size_t)m * D) + F.lane;
#pragma unroll
        for (int j = 0; j < 4; ++j) { const int col = F.lane * 4 + 256 * j;
            const f32x4 g = *(const f32x4*)(F.g_mix + col), sh = *(const f32x4*)(mb + col), sc = *(const f32x4*)(mb + 1024 + col);
            const float a0 = v[j].x * rstd * g.x * (1.f + sc.x) + sh.x, a1 = v[j].y * rstd * g.y * (1.f + sc.y) + sh.y, a2 = v[j].z * rstd * g.z * (1.f + sc.z) + sh.z, a3 = v[j].w * rstd * g.w * (1.f + sc.w) + sh.w;
            o8[64 * j] = (unsigned long long)pk2(a0, a1) | ((unsigned long long)pk2(a2, a3) << 32); }
    }
}

__device__ __forceinline__ void ph_rope(Frame& F) {
    const int gw = F.bid * NWAVES + F.wave, NGW = F.G * NWAVES;
    for (int m = gw; m < T; m += NGW) {
        const int pos = m & (SEQ - 1); bf16* row = F.QKV + (size_t)m * NQKV;
        for (int p = F.lane; p < 26 * 32; p += 64) {
            const int hd = p >> 5, i = p & 31;
            const int cbase = (hd < 16) ? hd * 64 : (hd < 24 ? C_SQ + (hd - 16) * 64 : C_SK + (hd - 24) * 64);
            const float cs = F.rope[pos * 32 + i], sn = F.rope[SEQ * 32 + pos * 32 + i];
            const float x1 = bflo(row[cbase + i]), x2 = bflo(row[cbase + 32 + i]);
            row[cbase + i] = (bf16)f2bf(x1 * cs - x2 * sn); row[cbase + 32 + i] = (bf16)f2bf(x2 * cs + x1 * sn);
        }
    }
}

__device__ __forceinline__ int opaque_zero() { int z; asm volatile("v_mov_b32 %0, 0" : "=v"(z)); return z; }
__device__ __forceinline__ void ph_attn_naive(Frame& F) {
    const int gw = F.bid * NWAVES + F.wave, NGW = F.G * NWAVES;
    const int z = opaque_zero();
    for (int s_ = gw; s_ < 8192; s_ += NGW) {
        const int r = s_ >> 11, gq = s_ & 2047, g = gq >> 8, combo = gq & 255;
        const int qblk = (r == 0) ? 31 - g : (r == 1) ? 16 + g : (r == 2) ? 15 - g : g;
        const int sub = combo & 1, h = (combo >> 1) & 3, b = combo >> 3;
        const int q = qblk * 64 + F.lane; const size_t tok = (size_t)b * SEQ + q;
        float qv[64];
        { const v4u* qp = (const v4u*)(F.QKV + tok * NQKV + C_DQ + h * 128 + sub * 64);
#pragma unroll
          for (int i = 0; i < 8; ++i) { const v4u w = qp[i]; qv[8 * i] = bflo(w.x); qv[8 * i + 1] = bfhi(w.x); qv[8 * i + 2] = bflo(w.y); qv[8 * i + 3] = bfhi(w.y); qv[8 * i + 4] = bflo(w.z); qv[8 * i + 5] = bfhi(w.z); qv[8 * i + 6] = bflo(w.w); qv[8 * i + 7] = bfhi(w.w); } }
        float o[128];
#pragma unroll
        for (int e = 0; e < 128; ++e) o[e] = 0.f;
        float mx = -1e30f, l = 0.f;
        const bf16* kbase = F.QKV + (size_t)b * SEQ * NQKV + C_DK + h * 128 + sub * 64 + z;
        const bf16* vbase = F.QKV + (size_t)b * SEQ * NQKV + C_DV + h * 128 + z;
        const int jend = qblk * 64 + 64;
        for (int j = 0; j < jend; ++j) {
            const v4u* kp = (const v4u*)(kbase + (size_t)j * NQKV);
            float s = 0.f;
#pragma unroll
            for (int i = 0; i < 8; ++i) { const v4u w = kp[i];
                s += qv[8 * i] * bflo(w.x) + qv[8 * i + 1] * bfhi(w.x) + qv[8 * i + 2] * bflo(w.y) + qv[8 * i + 3] * bfhi(w.y) + qv[8 * i + 4] * bflo(w.z) + qv[8 * i + 5] * bfhi(w.z) + qv[8 * i + 6] * bflo(w.w) + qv[8 * i + 7] * bfhi(w.w); }
            const bool valid = (j <= q);
            s = valid ? s * 0.125f : -1e30f;
            if (__any(s > mx)) { const float mn = fmaxf(mx, s), a = __expf(mx - mn); l *= a;
#pragma unroll
                for (int e = 0; e < 128; ++e) o[e] *= a;
                mx = mn; }
            const float p = valid ? __expf(s - mx) : 0.f;
            l += p;
            const v4u* vp = (const v4u*)(vbase + (size_t)j * NQKV);
#pragma unroll
            for (int i = 0; i < 16; ++i) { const v4u w = vp[i];
                o[8 * i] += p * bflo(w.x); o[8 * i + 1] += p * bfhi(w.x); o[8 * i + 2] += p * bflo(w.y); o[8 * i + 3] += p * bfhi(w.y); o[8 * i + 4] += p * bflo(w.z); o[8 * i + 5] += p * bfhi(w.z); o[8 * i + 6] += p * bflo(w.w); o[8 * i + 7] += p * bfhi(w.w); }
        }
        const float rl = 1.f / l;
        f32x4* op = (f32x4*)(F.DIFFO + ((tok * 4 + h) * 2 + sub) * 128);
#pragma unroll
        for (int i = 0; i < 32; ++i) op[i] = (f32x4){o[4 * i] * rl, o[4 * i + 1] * rl, o[4 * i + 2] * rl, o[4 * i + 3] * rl};
    }
    for (int s_ = gw; s_ < 8192; s_ += NGW) {
        const int qblk = s_ & 31, hq = (s_ >> 5) & 7, b = s_ >> 8, kvh = hq >> 2;
        const int q = qblk * 64 + F.lane; const size_t tok = (size_t)b * SEQ + q;
        float qv[64];
        { const v4u* qp = (const v4u*)(F.QKV + tok * NQKV + C_SQ + hq * 64);
#pragma unroll
          for (int i = 0; i < 8; ++i) { const v4u w = qp[i]; qv[8 * i] = bflo(w.x); qv[8 * i + 1] = bfhi(w.x); qv[8 * i + 2] = bflo(w.y); qv[8 * i + 3] = bfhi(w.y); qv[8 * i + 4] = bflo(w.z); qv[8 * i + 5] = bfhi(w.z); qv[8 * i + 6] = bflo(w.w); qv[8 * i + 7] = bfhi(w.w); } }
        float o[64];
#pragma unroll
        for (int e = 0; e < 64; ++e) o[e] = 0.f;
        float mx = -1e30f, l = 0.f;
        const bf16* kbase = F.QKV + (size_t)b * SEQ * NQKV + C_SK + kvh * 64 + z;
        const bf16* vbase = F.QKV + (size_t)b * SEQ * NQKV + C_SV + kvh * 64 + z;
        const int jbeg = (qblk * 64 - 127) > 0 ? (qblk * 64 - 127) : 0, jend = qblk * 64 + 64;
        for (int j = jbeg; j < jend; ++j) {
            const v4u* kp = (const v4u*)(kbase + (size_t)j * NQKV);
            float s = 0.f;
#pragma unroll
            for (int i = 0; i < 8; ++i) { const v4u w = kp[i];
                s += qv[8 * i] * bflo(w.x) + qv[8 * i + 1] * bfhi(w.x) + qv[8 * i + 2] * bflo(w.y) + qv[8 * i + 3] * bfhi(w.y) + qv[8 * i + 4] * bflo(w.z) + qv[8 * i + 5] * bfhi(w.z) + qv[8 * i + 6] * bflo(w.w) + qv[8 * i + 7] * bfhi(w.w); }
            const bool valid = (j <= q) && (q - j < 128);
            s = valid ? s * 0.125f : -1e30f;
            if (__any(s > mx)) { const float mn = fmaxf(mx, s), a = __expf(mx - mn); l *= a;
#pragma unroll
                for (int e = 0; e < 64; ++e) o[e] *= a;
                mx = mn; }
            const float p = valid ? __expf(s - mx) : 0.f;
            l += p;
            const v4u* vp = (const v4u*)(vbase + (size_t)j * NQKV);
#pragma unroll
            for (int i = 0; i < 8; ++i) { const v4u w = vp[i];
                o[8 * i] += p * bflo(w.x); o[8 * i + 1] += p * bfhi(w.x); o[8 * i + 2] += p * bflo(w.y); o[8 * i + 3] += p * bfhi(w.y); o[8 * i + 4] += p * bflo(w.z); o[8 * i + 5] += p * bfhi(w.z); o[8 * i + 6] += p * bflo(w.w); o[8 * i + 7] += p * bfhi(w.w); }
        }
        l += __expf(F.swa_sinks[hq] - mx);
        const float rl = 1.f / l;
        v4u* op = (v4u*)(F.ACT + tok * D + 512 + hq * 64);
#pragma unroll
        for (int i = 0; i < 8; ++i) { v4u w; w.x = pk2(o[8 * i] * rl, o[8 * i + 1] * rl); w.y = pk2(o[8 * i + 2] * rl, o[8 * i + 3] * rl); w.z = pk2(o[8 * i + 4] * rl, o[8 * i + 5] * rl); w.w = pk2(o[8 * i + 6] * rl, o[8 * i + 7] * rl); op[i] = w; }
    }
}

__device__ __forceinline__ float diff_lambda_value(Frame& F) {
    const float a = F.diff_lambda[F.lane] * F.diff_lambda[64 + F.lane], b = F.diff_lambda[128 + F.lane] * F.diff_lambda[192 + F.lane];
    return __expf(wave_sum(a)) - __expf(wave_sum(b)) + 0.2f;
}
__device__ __forceinline__ void ph_diff_combine(Frame& F) {
    const int gw = F.bid * NWAVES + F.wave, NGW = F.G * NWAVES;
    const float lam = diff_lambda_value(F);
    const int hh = F.lane >> 4, d0 = (F.lane & 15) * 8;
    const f32x4 g0 = *(const f32x4*)(F.g_diff_sub + d0), g1 = *(const f32x4*)(F.g_diff_sub + d0 + 4);
    for (int m = gw; m < T; m += NGW) {
        const float* p1 = F.DIFFO + (((size_t)m * 4 + hh) * 2 + 0) * 128 + d0; const float* p2 = p1 + 128;
        const f32x4 a0 = *(const f32x4*)p1, a1 = *(const f32x4*)(p1 + 4), b0 = *(const f32x4*)p2, b1 = *(const f32x4*)(p2 + 4);
        const f32x4 v0 = a0 - b0 * lam, v1 = a1 - b1 * lam;
        float ss = (v0.x * v0.x + v0.y * v0.y) + (v0.z * v0.z + v0.w * v0.w) + (v1.x * v1.x + v1.y * v1.y) + (v1.z * v1.z + v1.w * v1.w);
#pragma unroll
        for (int o = 1; o < 16; o <<= 1) ss += __shfl_xor(ss, o);
        const float r = 0.8f / sqrtf(ss * (1.f / 128.f) + EPS);
        v4u w; w.x = pk2(v0.x * r * g0.x, v0.y * r * g0.y); w.y = pk2(v0.z * r * g0.z, v0.w * r * g0.w); w.z = pk2(v1.x * r * g1.x, v1.y * r * g1.y); w.w = pk2(v1.z * r * g1.z, v1.w * r * g1.w);
        *(v4u*)(F.ACT + (size_t)m * D + hh * 128 + d0) = w;
    }
}

__device__ __forceinline__ void ph_norm2_route(Frame& F) {
    LAS float* WrT = (LAS float*)F.lds;
    LAS int* rinfo = (LAS int*)(F.lds + 81920);
    LAS int* hist = (LAS int*)(F.lds + 81920 + 4096);
    for (int idx = F.tid; idx < 20 * 1024; idx += NWAVES * 64) { const int c = idx >> 10, k = idx & 1023; WrT[idx] = (c < 4) ? F.w_rg[k * 4 + c] : F.w_re[k * 16 + (c - 4)]; }
    for (int chunk = F.bid; chunk < T / 256; chunk += F.G) {
        if (F.tid < 32) hist[F.tid] = 0;
        __syncthreads();
        for (int rr = 0; rr < 32; ++rr) {
            const int lt = F.wave * 32 + rr, m = chunk * 256 + lt, b = m >> 11;
            const float* mb = F.mod + b * 6144;
            const f32x4* xr = (const f32x4*)(F.x + (size_t)m * D) + F.lane;
            const unsigned long long* mr = (const unsigned long long*)(F.MIX + (size_t)m * D) + F.lane;
            f32x4* x1r = (f32x4*)(F.out + (size_t)m * D) + F.lane;
            f32x4 v[4]; float s = 0.f;
#pragma unroll
            for (int j = 0; j < 4; ++j) { const int col = F.lane * 4 + 256 * j; const f32x4 xv = xr[64 * j]; const unsigned long long mw = mr[64 * j]; const f32x4 gt = *(const f32x4*)(mb + 2048 + col);
                const unsigned lo = (unsigned)mw, hi = (unsigned)(mw >> 32);
                v[j].x = xv.x + gt.x * bflo(lo); v[j].y = xv.y + gt.y * bfhi(lo); v[j].z = xv.z + gt.z * bflo(hi); v[j].w = xv.w + gt.w * bfhi(hi);
                x1r[64 * j] = v[j];
                s += (v[j].x * v[j].x + v[j].y * v[j].y) + (v[j].z * v[j].z + v[j].w * v[j].w); }
            const float rstd = 1.f / sqrtf(wave_sum(s) * (1.f / D) + EPS);
            unsigned long long* o8 = (unsigned long long*)(F.ACT + (size_t)m * D) + F.lane;
#pragma unroll
            for (int j = 0; j < 4; ++j) { const int col = F.lane * 4 + 256 * j;
                const f32x4 g = *(const f32x4*)(F.g_ffn + col), sh = *(const f32x4*)(mb + 3072 + col), sc = *(const f32x4*)(mb + 4096 + col);
                v[j].x = v[j].x * rstd * g.x * (1.f + sc.x) + sh.x; v[j].y = v[j].y * rstd * g.y * (1.f + sc.y) + sh.y; v[j].z = v[j].z * rstd * g.z * (1.f + sc.z) + sh.z; v[j].w = v[j].w * rstd * g.w * (1.f + sc.w) + sh.w;
                o8[64 * j] = (unsigned long long)pk2(v[j].x, v[j].y) | ((unsigned long long)pk2(v[j].z, v[j].w) << 32); }
            float lg[20];
#pragma unroll
            for (int c = 0; c < 20; ++c) { float a = 0.f;
#pragma unroll
                for (int j = 0; j < 4; ++j) { const f32x4 w = *(const LAS f32x4*)(WrT + c * 1024 + F.lane * 4 + 256 * j); a += (v[j].x * w.x + v[j].y * w.y) + (v[j].z * w.z + v[j].w * w.w); }
                lg[c] = wave_sum(a); }
            if (F.lane == 0) {
                float gl[4];
#pragma unroll
                for (int g = 0; g < 4; ++g) gl[g] = lg[g] + F.b_rg[g];
                int gi = 0; float gm = gl[0];
#pragma unroll
                for (int g = 1; g < 4; ++g) if (gl[g] > gm) { gm = gl[g]; gi = g; }
                float gs = 0.f;
#pragma unroll
                for (int g = 0; g < 4; ++g) gs += __expf(gl[g] - gm);
                const float grp_p = 1.f / gs;
                float el[4];
#pragma unroll
                for (int i = 0; i < 4; ++i) { float a = lg[4 + i] + F.b_re[i], b2 = lg[8 + i] + F.b_re[4 + i], c2 = lg[12 + i] + F.b_re[8 + i], d2 = lg[16 + i] + F.b_re[12 + i]; el[i] = (gi == 0) ? a : (gi == 1) ? b2 : (gi == 2) ? c2 : d2; }
                int i0 = 0; float m0 = el[0];
#pragma unroll
                for (int i = 1; i < 4; ++i) if (el[i] > m0) { m0 = el[i]; i0 = i; }
                int i1 = -1; float m1 = -3.0e38f;
#pragma unroll
                for (int i = 0; i < 4; ++i) if (i != i0 && el[i] > m1) { m1 = el[i]; i1 = i; }
                const float t = __expf(m1 - m0); const float w0 = grp_p / (1.f + t), w1 = grp_p * t / (1.f + t);
                rinfo[lt * 4 + 0] = gi * 4 + i0; rinfo[lt * 4 + 1] = gi * 4 + i1; rinfo[lt * 4 + 2] = __builtin_bit_cast(int, w0); rinfo[lt * 4 + 3] = __builtin_bit_cast(int, w1);
            }
        }
        __syncthreads();
        int e0 = 0, e1 = 0, r0 = 0, r1 = 0;
        if (F.tid < 256) { e0 = rinfo[F.tid * 4]; e1 = rinfo[F.tid * 4 + 1]; r0 = __hip_atomic_fetch_add(&hist[e0], 1, __ATOMIC_RELAXED, __HIP_MEMORY_SCOPE_WORKGROUP); r1 = __hip_atomic_fetch_add(&hist[e1], 1, __ATOMIC_RELAXED, __HIP_MEMORY_SCOPE_WORKGROUP); }
        __syncthreads();
        if (F.tid < 16) hist[16 + F.tid] = (int)__hip_atomic_fetch_add(F.ctl + CW_CNT + F.tid, (unsigned)hist[F.tid], RLX_AGENT);
        __syncthreads();
        if (F.tid < 256) { const int m = chunk * 256 + F.tid; r0 += hist[16 + e0]; r1 += hist[16 + e1];
            F.list[e0 * T + r0] = m; F.list[e1 * T + r1] = m;
            F.tok_e[m] = e0 | (e1 << 8); F.tok_r0[m] = r0; F.tok_r1[m] = r1; F.tok_w0[m] = __builtin_bit_cast(float, rinfo[F.tid * 4 + 2]); F.tok_w1[m] = __builtin_bit_cast(float, rinfo[F.tid * 4 + 3]); }
        __syncthreads();
    }
}

__device__ __forceinline__ void load_tstart(Frame& F, LAS int* ts) {
    if (F.tid == 0) { int acc = 0;
        for (int e = 0; e < 16; ++e) { ts[e] = acc; const int n = (int)__hip_atomic_load(F.ctl + CW_CNT + e, RLX_AGENT); ts[32 + e] = n; acc += (n + 255) >> 8; }
        ts[16] = acc; }
    __syncthreads();
}

__device__ __forceinline__ void ph_gather(Frame& F) {
    LAS int* ts = (LAS int*)(F.lds + RING_BYTES);
    load_tstart(F, ts);
    const int gw = F.bid * NWAVES + F.wave, NGW = F.G * NWAVES; const int R = ts[16];
    for (int pos = gw; pos < R * 256; pos += NGW) {
        const int rt = pos >> 8; int e = 0;
#pragma unroll
        for (int k = 1; k < 16; ++k) e += (rt >= ts[k]) ? 1 : 0;
        const int rk = pos - 256 * ts[e], n = ts[32 + e];
        const int tok = __hip_atomic_load((unsigned*)F.list + e * T + (rk < n ? rk : 0), RLX_AGENT);
        const v4u* src = (const v4u*)(F.ACT + (size_t)tok * D) + F.lane; v4u* dst = (v4u*)(F.HS + (size_t)pos * D) + F.lane;
        dst[0] = src[0]; dst[64] = src[64];
    }
}

__device__ __forceinline__ void ph_act(Frame& F) {
    LAS int* ts = (LAS int*)(F.lds + RING_BYTES);
    load_tstart(F, ts);
    const int gw = F.bid * NWAVES + F.wave, NGW = F.G * NWAVES; const int R = ts[16];
    for (int pos = gw; pos < R * 256; pos += NGW) {
        const v4u g = *((const v4u*)(F.GU + (size_t)pos * 1024) + F.lane), u = *((const v4u*)(F.GU + (size_t)pos * 1024 + 512) + F.lane);
        v4u o;
#define SILU_MUL(gw_, uw_) pk2(bflo(gw_) / (1.f + __expf(-bflo(gw_))) * bflo(uw_), bfhi(gw_) / (1.f + __expf(-bfhi(gw_))) * bfhi(uw_))
        o.x = SILU_MUL(g.x, u.x); o.y = SILU_MUL(g.y, u.y); o.z = SILU_MUL(g.z, u.z); o.w = SILU_MUL(g.w, u.w);
#undef SILU_MUL
        *((v4u*)(F.ACTM + (size_t)pos * 512) + F.lane) = o;
    }
}

__device__ __forceinline__ void ph_final(Frame& F) {
    LAS int* ts = (LAS int*)(F.lds + RING_BYTES);
    load_tstart(F, ts);
    const int gw = F.bid * NWAVES + F.wave, NGW = F.G * NWAVES;
    for (int m = gw; m < T; m += NGW) {
        const int b = m >> 11; const float* mb = F.mod + b * 6144;
        const int ee = F.tok_e[m], e0 = ee & 255, e1 = ee >> 8;
        const size_t p0 = (size_t)256 * ts[e0] + F.tok_r0[m], p1 = (size_t)256 * ts[e1] + F.tok_r1[m];
        const float w0 = F.tok_w0[m], w1 = F.tok_w1[m];
        f32x4* xr = (f32x4*)(F.out + (size_t)m * D) + F.lane;
        const unsigned long long* y0 = (const unsigned long long*)(F.Y + p0 * D) + F.lane; const unsigned long long* y1 = (const unsigned long long*)(F.Y + p1 * D) + F.lane;
        f32x4 v[4]; float s = 0.f;
#pragma unroll
        for (int j = 0; j < 4; ++j) { const int col = F.lane * 4 + 256 * j; const f32x4 xv = xr[64 * j]; const unsigned long long a = y0[64 * j], c = y1[64 * j]; const f32x4 gt = *(const f32x4*)(mb + 5120 + col);
            const unsigned al = (unsigned)a, ah = (unsigned)(a >> 32), cl = (unsigned)c, ch = (unsigned)(c >> 32);
            v[j].x = xv.x + gt.x * (w0 * bflo(al) + w1 * bflo(cl)); v[j].y = xv.y + gt.y * (w0 * bfhi(al) + w1 * bfhi(cl)); v[j].z = xv.z + gt.z * (w0 * bflo(ah) + w1 * bflo(ch)); v[j].w = xv.w + gt.w * (w0 * bfhi(ah) + w1 * bfhi(ch));
            s += (v[j].x * v[j].x + v[j].y * v[j].y) + (v[j].z * v[j].z + v[j].w * v[j].w); }
        const float rstd = 1.f / sqrtf(wave_sum(s) * (1.f / D) + EPS);
#pragma unroll
        for (int j = 0; j < 4; ++j) { const int col = F.lane * 4 + 256 * j; const f32x4 g = *(const f32x4*)(F.g_final + col);
            xr[64 * j] = (f32x4){v[j].x * rstd * g.x, v[j].y * rstd * g.y, v[j].z * rstd * g.z, v[j].w * rstd * g.w}; }
    }
}

struct Args { const float* in[19]; float* out; unsigned char* ws; int ph_lo, ph_hi; };
__global__ void __launch_bounds__(NWAVES * 64, 2) mk_fwd(Args args) {
    extern __shared__ __attribute__((aligned(16))) unsigned char lds[];
    Frame F;
    F.lds = (LAS unsigned char*)lds;
    F.tid = threadIdx.x; F.lane = F.tid & 63; F.wave = __builtin_amdgcn_readfirstlane(F.tid >> 6);
    F.G = gridDim.x; F.bid = blockIdx.x;
    unsigned char* ws = args.ws; F.ws = ws; F.ctl = (unsigned*)(ws + WS_CTL);
    F.x = args.in[0]; F.c = args.in[1]; F.w_ada = args.in[2]; F.b_ada = args.in[3]; F.g_mix = args.in[4]; F.w_in = args.in[5]; F.diff_lambda = args.in[6]; F.g_diff_sub = args.in[7];
    F.swa_sinks = args.in[8]; F.w_out = args.in[9]; F.g_ffn = args.in[10]; F.w_rg = args.in[11]; F.b_rg = args.in[12]; F.w_re = args.in[13]; F.b_re = args.in[14];
    F.w_gate = args.in[15]; F.w_up = args.in[16]; F.w_down = args.in[17]; F.g_final = args.in[18]; F.out = args.out;
    F.mod = (float*)(ws + WS_MOD); F.rope = (float*)(ws + WS_ROPE);
    F.tok_e = (int*)(ws + WS_TOK); F.tok_r0 = F.tok_e + T; F.tok_r1 = F.tok_e + 2 * T; F.tok_w0 = (float*)(F.tok_e + 3 * T); F.tok_w1 = (float*)(F.tok_e + 4 * T);
    F.list = (int*)(ws + WS_LIST);
    F.WinT = (bf16*)(ws + WS_WIN); F.WoT = (bf16*)(ws + WS_WO); F.WguT = (bf16*)(ws + WS_WGU); F.WdT = (bf16*)(ws + WS_WD);
    F.ACT = (bf16*)(ws + WS_ACT); F.QKV = (bf16*)(ws + WS_QKV); F.MIX = (bf16*)(ws + WS_QKV); F.HS = (bf16*)(ws + WS_QKV); F.Y = (bf16*)(ws + WS_QKV);
    F.GU = (bf16*)(ws + WS_GU); F.DIFFO = (float*)(ws + WS_GU); F.ACTM = (bf16*)(ws + WS_ACTM);
    for (int u = F.tid; u < (LDS_BYTES - RING_BYTES) / 4; u += NWAVES * 64) ((LAS unsigned*)(F.lds + RING_BYTES))[u] = 0u;
    __syncthreads();
    XcdBarrier bar; bar.bar = (unsigned*)(F.ctl + CW_BAR); bar.x = 0; bar.st = nullptr;
#if MK_ONE_LAUNCH
    bar = xcd_barrier_post((unsigned*)(F.ctl + CW_BAR), (volatile LAS unsigned*)(F.lds + MISC_OFF));
#endif
    const int lo = args.ph_lo, hi = args.ph_hi;
#define IN(k) (lo <= (k) && (k) < hi)
#if MK_ONE_LAUNCH
#define SEAM(k) do { if (IN(k) && IN((k) + 1)) xcd_barrier(bar); } while (0)
#else
#define SEAM(k) do { } while (0)
#endif
    if (IN(0)) { ph_prologue(F); SEAM(0); }
    if (IN(1)) { ph_norm1(F); SEAM(1); }
    if (IN(2)) {
        pg8::Gemm g{F.ACT, F.WinT, T, NQKV, D, 0}; pg8::StaticOrder S; S.init(T, NQKV, F.G, F.bid);
        pg8::EpiPlain E{F.QKV, NQKV};
        pg8::gemm_phase<pg8::EpiPlain, pg8::StaticOrder, true, true>(F.lds, g, S, E);
        SEAM(2);
    }
    if (IN(3)) { ph_rope(F); SEAM(3); }
    if (IN(4)) { ph_attn_naive(F); SEAM(4); }
    if (IN(5)) { ph_diff_combine(F); SEAM(5); }
    if (IN(6)) {
        pg8::Gemm g{F.ACT, F.WoT, T, D, D, 0}; pg8::StaticOrder S; S.init(T, D, F.G, F.bid);
        pg8::EpiPlain E{F.MIX, D};
        pg8::gemm_phase<pg8::EpiPlain, pg8::StaticOrder, true, true>(F.lds, g, S, E);
        SEAM(6);
    }
    if (IN(7)) { ph_norm2_route(F); SEAM(7); }
    if (IN(8)) { ph_gather(F); SEAM(8); }
    if (IN(9)) {
        LAS int* ts = (LAS int*)(F.lds + RING_BYTES); load_tstart(F, ts);
        pg8::Gemm g{F.HS, F.WguT, SORT_ROWS, 1024, D, (size_t)1024 * 1024 * 2}; pg8::MoeOrder S{4, F.G, F.bid, __builtin_amdgcn_readfirstlane(ts[16]), (const PG8_LAS int*)ts};
        pg8::EpiPlain E{F.GU, 1024};
        pg8::gemm_phase<pg8::EpiPlain, pg8::MoeOrder, true, true>(F.lds, g, S, E);
        SEAM(9);
    }
    if (IN(10)) { ph_act(F); SEAM(10); }
    if (IN(11)) {
        LAS int* ts = (LAS int*)(F.lds + RING_BYTES); load_tstart(F, ts);
        pg8::Gemm g{F.ACTM, F.WdT, SORT_ROWS, 1024, DEXP, (size_t)1024 * 512 * 2}; pg8::MoeOrder S{4, F.G, F.bid, __builtin_amdgcn_readfirstlane(ts[16]), (const PG8_LAS int*)ts};
        pg8::EpiPlain E{F.Y, 1024};
        pg8::gemm_phase<pg8::EpiPlain, pg8::MoeOrder, true, true>(F.lds, g, S, E);
        SEAM(11);
    }
    if (IN(12)) { ph_final(F); }
#undef IN
#undef SEAM
}

extern "C" void kernel_launch(void* const* d_in, const int* in_sizes, int n_in, void* d_out, int out_size, void* d_ws, size_t ws_size, hipStream_t stream) {
    static int grid = 0;
    if (grid == 0) {
        if (n_in != 19 || in_sizes[0] != T * D || out_size != T * D || ws_size < WS_END) { fprintf(stderr, "kernel_launch: unexpected shapes/workspace: n_in %d in0 %d out %d ws %zu (need %zu); nothing launched\n", n_in, n_in > 0 ? in_sizes[0] : -1, out_size, ws_size, (size_t)WS_END); grid = -1; return; }
        int dev = 0, cus = 0, per_cu = 0;
        if (hipGetDevice(&dev) != hipSuccess || hipDeviceGetAttribute(&cus, hipDeviceAttributeMultiprocessorCount, dev) != hipSuccess) { fprintf(stderr, "kernel_launch: device query failed\n"); grid = -1; return; }
        if (hipFuncSetAttribute((const void*)mk_fwd, hipFuncAttributeMaxDynamicSharedMemorySize, LDS_BYTES) != hipSuccess) { fprintf(stderr, "kernel_launch: hipFuncSetAttribute failed\n"); grid = -1; return; }
        if (hipOccupancyMaxActiveBlocksPerMultiprocessor(&per_cu, (const void*)mk_fwd, NWAVES * 64, LDS_BYTES) != hipSuccess || per_cu < 1)
            fprintf(stderr, "kernel_launch: note: occupancy query reports %d workgroups per CU\n", per_cu);
        (void)hipGetLastError();
        grid = cus;
    }
    if (grid < 0) return;
    if (hipMemsetAsync((char*)d_ws + WS_CTL, 0, CTL_ZERO_BYTES, stream) != hipSuccess) { fprintf(stderr, "kernel_launch: memset failed\n"); return; }
    Args a{};
    for (int i = 0; i < 19; ++i) a.in[i] = (const float*)d_in[i];
    a.out = (float*)d_out; a.ws = (unsigned char*)d_ws;
#if MK_ONE_LAUNCH
    a.ph_lo = 0; a.ph_hi = N_PHASES;
    hipLaunchKernelGGL(mk_fwd, dim3(grid), dim3(NWAVES * 64), LDS_BYTES, stream, a);
#else
    for (int p = 0; p < N_PHASES; ++p) { a.ph_lo = p; a.ph_hi = p + 1; hipLaunchKernelGGL(mk_fwd, dim3(grid), dim3(NWAVES * 64), LDS_BYTES, stream, a); }
#endif
    const hipError_t le = hipPeekAtLastError();
    if (le != hipSuccess) fprintf(stderr, "kernel_launch: launch failed: %s\n", hipGetErrorName(le));
}
```

```cpp
#include <hip/hip_runtime.h>
#include <cstdio>
#include <cstdint>
namespace pg8 {
#define PG8_LAS __attribute__((address_space(3)))
typedef unsigned short bf16_t;
typedef short bf16x8 __attribute__((ext_vector_type(8)));
typedef float f32x4 __attribute__((ext_vector_type(4)));
typedef unsigned u32x4 __attribute__((ext_vector_type(4)));
constexpr int BM = 256, BK = 64, HALF = 128, HTB = HALF * BK * 2  , STAGE_BYTES = 8 * HTB, NXCD = 8, WGM = 8;

__host__ __device__ __forceinline__ int lds_byte(int r, int c) { const int st = (r >> 4) * 2 + (c >> 5), rr = r & 15, cc = c & 31, ob = rr * 64 + cc * 2; return st * 1024 + (ob ^ (((ob >> 9) & 1) << 5)); }
__host__ __device__ __forceinline__ void stage_rc(int b, int& R, int& C) { const int st = b / 1024, sb = b % 1024, swz = sb ^ (((sb >> 9) & 1) << 5); R = (st >> 1) * 16 + swz / 64; C = (st & 1) * 32 + (swz % 64) / 2; }
__host__ __device__ __forceinline__ int perm32(int rho) { const int n = rho >> 4, i = rho & 15; return 8 * (i >> 2) + 4 * n + (i & 3); }

struct Unit { int pm, pn, e; };
struct Gemm { const bf16_t* A; const bf16_t* Bt; int M, N, K; size_t bstride; };

struct StaticOrder {
    int nM, nN, nwg, G, c;
    __host__ __device__ void init(int M, int N, int G_, int c_) { nM = M / BM; nN = N / BM; nwg = nM * nN; G = G_; c = c_; }
    __host__ __device__ bool next(int i, Unit& u) const {
        const long L = (long)i * G + c; if (L >= nwg) return false;
        int wgid = (int)L; { const int q = nwg / NXCD, r = nwg % NXCD, xcd = wgid % NXCD, off = wgid / NXCD; wgid = (xcd < r ? xcd * (q + 1) : r * (q + 1) + (xcd - r) * q) + off; }
        const int nig = WGM * nN, gid = wgid / nig, fm = gid * WGM, gsz = (nM - fm) < WGM ? (nM - fm) : WGM;
        u.pm = fm + ((wgid % nig) % gsz); u.pn = (wgid % nig) / gsz; u.e = 0; return true;
    }
    __device__ __forceinline__ void a_ready(const Unit&) const {}
    __device__ __forceinline__ void done(const Unit&) const {}
};

__device__ __forceinline__ unsigned cvt_pk_bf16(float lo, float hi) { unsigned r; asm volatile("v_cvt_pk_bf16_f32 %0, %1, %2" : "=v"(r) : "v"(lo), "v"(hi)); return r; }
typedef float f32x2 __attribute__((ext_vector_type(2)));
typedef unsigned u32x2 __attribute__((ext_vector_type(2)));
typedef int v4i_t __attribute__((ext_vector_type(4)));
typedef int v8i_t __attribute__((ext_vector_type(8)));

struct EpiPlain {
    static constexpr bool PERM = true, AFTER_DRAIN = false;
    bf16_t* O; int ldc;
    __device__ __forceinline__ void operator()(const f32x4 (&acc)[2][2][4][2], const Unit& u, int wr, int wc, int fr, int fq) const {
        const int row0 = u.pm * BM + wr * 64 + fr; const int col0 = u.pn * BM + wc * 32 + 8 * fq;
#pragma unroll
        for (int ai = 0; ai < 2; ++ai)
#pragma unroll
            for (int m = 0; m < 4; ++m) { bf16_t* rowp = O + (size_t)(row0 + ai * HALF + m * 16) * ldc + col0;
#pragma unroll
                for (int bj = 0; bj < 2; ++bj) { const f32x4 v0 = acc[ai][bj][m][0], v1 = acc[ai][bj][m][1];
                    u32x4 w; w.x = cvt_pk_bf16(v0[0], v0[1]); w.y = cvt_pk_bf16(v0[2], v0[3]); w.z = cvt_pk_bf16(v1[0], v1[1]); w.w = cvt_pk_bf16(v1[2], v1[3]);
                    *(u32x4*)(rowp + bj * HALF) = w; } }
    }
};
struct EpiPlain8 {
    static constexpr bool PERM = true, AFTER_DRAIN = false;
    unsigned char* O; int ldc;
    __device__ __forceinline__ void operator()(const f32x4 (&acc)[2][2][4][2], const Unit& u, int wr, int wc, int fr, int fq) const {
        const int row0 = u.pm * BM + wr * 64 + fr; const int col0 = u.pn * BM + wc * 32 + 8 * fq;
#pragma unroll
        for (int ai = 0; ai < 2; ++ai)
#pragma unroll
            for (int m = 0; m < 4; ++m) { unsigned char* rowp = O + (size_t)(row0 + ai * HALF + m * 16) * ldc + col0;
#pragma unroll
                for (int bj = 0; bj < 2; ++bj) { f32x4 v0 = acc[ai][bj][m][0], v1 = acc[ai][bj][m][1];
#pragma unroll
                    for (int j = 0; j < 4; ++j) { v0[j] = __builtin_fminf(__builtin_fmaxf(v0[j], -448.f), 448.f); v1[j] = __builtin_fminf(__builtin_fmaxf(v1[j], -448.f), 448.f); }
                    int w0 = 0, w1 = 0; w0 = __builtin_amdgcn_cvt_pk_fp8_f32(v0[0], v0[1], w0, false); w0 = __builtin_amdgcn_cvt_pk_fp8_f32(v0[2], v0[3], w0, true);
                    w1 = __builtin_amdgcn_cvt_pk_fp8_f32(v1[0], v1[1], w1, false); w1 = __builtin_amdgcn_cvt_pk_fp8_f32(v1[2], v1[3], w1, true);
                    *(u32x2*)(rowp + bj * HALF) = (u32x2){(unsigned)w0, (unsigned)w1}; } }
    }
};
struct EpiRope {
    static constexpr bool PERM = true, AFTER_DRAIN = false;
    bf16_t* O; int ldc; const float* rope;
    __device__ __forceinline__ void operator()(const f32x4 (&acc)[2][2][4][2], const Unit& u, int wr, int wc, int fr, int fq) const {
        const int row0 = u.pm * BM + wr * 64 + fr; const int col0 = u.pn * BM + wc * 32 + 8 * fq; const int fi = 16 * (wc & 1) + 4 * fq;
#pragma unroll
        for (int ai = 0; ai < 2; ++ai)
#pragma unroll
            for (int m = 0; m < 4; ++m) { const int row = row0 + ai * HALF + m * 16, pos = row & 2047; bf16_t* rowp = O + (size_t)row * ldc + col0;
                const f32x4 cs = *(const f32x4*)(rope + pos * 32 + fi), sn = *(const f32x4*)(rope + 65536 + pos * 32 + fi);
#pragma unroll
                for (int bj = 0; bj < 2; ++bj) { const int cb = u.pn * BM + bj * HALF; const bool rp = cb < 1024 || (cb >= 1536 && cb <= 2048); const float qs = (cb < 512 || (cb >= 1536 && cb < 2048)) ? 0.18033688011112042f : 1.f;
                    f32x4 v0 = acc[ai][bj][m][0], v1 = acc[ai][bj][m][1];
                    if (rp) { const f32x4 a = (v0 * cs - v1 * sn) * qs, b = (v1 * cs + v0 * sn) * qs; v0 = a; v1 = b; }
                    u32x4 w; w.x = cvt_pk_bf16(v0[0], v0[1]); w.y = cvt_pk_bf16(v0[2], v0[3]); w.z = cvt_pk_bf16(v1[0], v1[1]); w.w = cvt_pk_bf16(v1[2], v1[3]);
                    *(u32x4*)(rowp + bj * HALF) = w; } }
    }
};
struct EpiResid {
    static constexpr bool PERM = true, AFTER_DRAIN = false;
    const float* x; bf16_t* out; const float* mod;
    __device__ __forceinline__ void operator()(const f32x4 (&acc)[2][2][4][2], const Unit& u, int wr, int wc, int fr, int fq) const {
        const int row0 = u.pm * BM + wr * 64 + fr; const int col0 = u.pn * BM + wc * 32 + 8 * fq; const float* gtp = mod + ((u.pm * BM) >> 11) * 6144 + 2048 + col0;
        f32x4 gt[2][2];
#pragma unroll
        for (int bj = 0; bj < 2; ++bj) { gt[bj][0] = *(const f32x4*)(gtp + bj * HALF); gt[bj][1] = *(const f32x4*)(gtp + bj * HALF + 4); }
#pragma unroll
        for (int ai = 0; ai < 2; ++ai)
#pragma unroll
            for (int m = 0; m < 4; ++m) { const size_t off = (size_t)(row0 + ai * HALF + m * 16) * 1024 + col0;
#pragma unroll
                for (int bj = 0; bj < 2; ++bj) { const f32x4 x0 = *(const f32x4*)(x + off + bj * HALF), x1 = *(const f32x4*)(x + off + bj * HALF + 4);
                    const f32x4 v0 = x0 + gt[bj][0] * acc[ai][bj][m][0], v1 = x1 + gt[bj][1] * acc[ai][bj][m][1];
                    u32x4 w; w.x = cvt_pk_bf16(v0[0], v0[1]); w.y = cvt_pk_bf16(v0[2], v0[3]); w.z = cvt_pk_bf16(v1[0], v1[1]); w.w = cvt_pk_bf16(v1[2], v1[3]);
                    *(u32x4*)(out + off + bj * HALF) = w; } }
    }
};
struct EpiSwiGLU {
    static constexpr bool PERM = true, AFTER_DRAIN = false;
    unsigned char* O;
    __device__ __forceinline__ void operator()(const f32x4 (&acc)[2][2][4][2], const Unit& u, int wr, int wc, int fr, int fq) const {
        const int row0 = u.pm * BM + wr * 64 + fr; const int col0 = u.pn * 128 + wc * 16 + 4 * fq;
#pragma unroll
        for (int ai = 0; ai < 2; ++ai)
#pragma unroll
            for (int m = 0; m < 4; ++m) { unsigned char* rowp = O + (size_t)(row0 + ai * HALF + m * 16) * 512 + col0;
#pragma unroll
                for (int bj = 0; bj < 2; ++bj) { const f32x4 gv = acc[ai][bj][m][0], uv = acc[ai][bj][m][1]; f32x4 a;
#pragma unroll
                    for (int j = 0; j < 4; ++j) { const float t = gv[j] * __builtin_amdgcn_rcpf(1.f + __builtin_amdgcn_exp2f(-1.4426950408889634f * gv[j])) * uv[j]; a[j] = __builtin_fminf(__builtin_fmaxf(t, -448.f), 448.f); }
                    int w = 0; w = __builtin_amdgcn_cvt_pk_fp8_f32(a[0], a[1], w, false); w = __builtin_amdgcn_cvt_pk_fp8_f32(a[2], a[3], w, true);
                    *(int*)(rowp + bj * 64) = w; } }
    }
};
struct MoeOrder {
    int nN, G, c, R; const PG8_LAS int* tstart;
    __device__ __forceinline__ bool next(int i, Unit& u) const {
        int rt, pn;
        if (G == 256 && nN == 4) { rt = i * 64 + (c >> 5) * 8 + (c & 7); pn = (c & 31) >> 3; if (rt >= R) return false; }
        else { const long L = (long)i * G + c; if (L >= (long)R * nN) return false; rt = (int)(L / nN); pn = (int)(L % nN); }
        u.pn = pn; u.pm = rt; int e = 0;
#pragma unroll
        for (int k = 1; k < 16; ++k) e += (rt >= tstart[k]) ? 1 : 0;
        u.e = __builtin_amdgcn_readfirstlane(e); return true;
    }
    __device__ __forceinline__ void a_ready(const Unit&) const {}
    __device__ __forceinline__ void done(const Unit&) const {}
};
template <class Epi, class Sched, bool ALIGN_EPI = false, bool SP2 = false, bool GATHER = false, bool FP8 = false>
__device__ __forceinline__ void gemm_phase(PG8_LAS unsigned char* lds, const Gemm g, const Sched& S, const Epi& E, const int wid  , const PG8_LAS unsigned* gath = nullptr) {
    int lane; asm volatile("v_mbcnt_lo_u32_b32 %0, -1, 0\n\tv_mbcnt_hi_u32_b32 %0, -1, %0" : "=v"(lane));
    const int tid = wid * 64 + lane, wr = wid >> 2, wc = wid & 3, fr = lane & 15, fq = lane >> 4;
    const int K = g.K, nt = K / BK;
    unsigned voffA[2], voffB[2], gC[2]; int gR[2];
#pragma unroll
    for (int i = 0; i < 2; ++i) { int R, C; stage_rc(tid * 16 + i * 8192, R, C); const int Rb = Epi::PERM ? ((R & ~31) + perm32(R & 31)) : R;
        voffA[i] = (unsigned)(R * K + C) * 2u; voffB[i] = (unsigned)(Rb * K + C) * 2u; gR[i] = R; gC[i] = (unsigned)C * 2u; }
    const unsigned kstep = (unsigned)(BK * 2);
    const unsigned hstep = (unsigned)HALF * (unsigned)K * 2u;
    const unsigned tstep = 2u * hstep;
    const char* const baseA = (const char*)g.A; const char* const baseB = (const char*)g.Bt;
    unsigned cv0[2], cv1[2], nv0[2], nv1[2];
#define PG8_GOFF(dst0, dst1, uidx) do { _Pragma("unroll") for (int _i = 0; _i < 2; ++_i) { if constexpr (GATHER) { dst0[_i] = gath[(uidx) * 256 + gR[_i]] + gC[_i]; dst1[_i] = gath[(uidx) * 256 + 128 + gR[_i]] + gC[_i]; } else { dst0[_i] = 0u; dst1[_i] = 0u; } } } while (0)
    const unsigned ldsw = (unsigned)wid * 1024u;
    const int aoff = lds_byte(wr * 64 + fr, fq * (FP8 ? 16 : 8)), boff = lds_byte(wc * 32 + fr, fq * (FP8 ? 16 : 8));

#define PG8_SA(b, h) (((b) * 2 + (h)) * HTB)
#define PG8_SB(b, h) ((4 + (b) * 2 + (h)) * HTB)
#define PG8_STAGE(bufoff, BASE, goff, voff) do { _Pragma("unroll") for (int _i = 0; _i < 2; ++_i) \
        __builtin_amdgcn_global_load_lds((const unsigned*)((BASE) + (unsigned)((goff) + (voff)[_i])), (PG8_LAS unsigned*)(lds + (bufoff) + ldsw + _i * 8192), 16, 0, 0); } while (0)
#define PG8_RD8(p_) __builtin_shufflevector(*(const PG8_LAS v4i_t*)(p_), *(const PG8_LAS v4i_t*)((p_) + 16), 0, 1, 2, 3, 4, 5, 6, 7)
#define PG8_STA(bufoff, gbase, H, X0, X1) do { if constexpr (GATHER) { PG8_STAGE(bufoff, baseA, gbase, (H ? X1 : X0)); } else { PG8_STAGE(bufoff, baseA, (gbase) + (H ? hstep : 0u), voffA); } } while (0)
#define PG8_LDA(dst, b, h) do { if constexpr (FP8) { _Pragma("unroll") for (int m = 0; m < 4; ++m) dst##8[m] = PG8_RD8(lds + PG8_SA(b, h) + aoff + m * 2048); } \
        else { _Pragma("unroll") for (int m = 0; m < 4; ++m) _Pragma("unroll") for (int k = 0; k < 2; ++k) dst[m][k] = *(const PG8_LAS bf16x8*)(lds + PG8_SA(b, h) + aoff + m * 2048 + k * 1024); } } while (0)
#define PG8_LDB(dst, b, h) do { if constexpr (FP8) { _Pragma("unroll") for (int n = 0; n < 2; ++n) dst##8[n] = PG8_RD8(lds + PG8_SB(b, h) + boff + n * 2048); } \
        else { _Pragma("unroll") for (int n = 0; n < 2; ++n) _Pragma("unroll") for (int k = 0; k < 2; ++k) dst[n][k] = *(const PG8_LAS bf16x8*)(lds + PG8_SB(b, h) + boff + n * 2048 + k * 1024); } } while (0)
#define PG8_MMA(ai, bj, At, Bt) do { __builtin_amdgcn_s_setprio(1); \
        if constexpr (FP8) { _Pragma("unroll") for (int m = 0; m < 4; ++m) _Pragma("unroll") for (int n = 0; n < 2; ++n) \
            acc[ai][bj][m][n] = __builtin_amdgcn_mfma_scale_f32_16x16x128_f8f6f4(Bt##8[n], At##8[m], acc[ai][bj][m][n], 0, 0, 0, scl, 1, scl); \
          _Pragma("unroll") for (int m = 0; m < 4; ++m) _Pragma("unroll") for (int n = 0; n < 2; ++n) asm volatile("" : "+v"(acc[ai][bj][m][n])); }   \
        else { _Pragma("unroll") for (int m = 0; m < 4; ++m) _Pragma("unroll") for (int n = 0; n < 2; ++n) _Pragma("unroll") for (int k = 0; k < 2; ++k) \
            acc[ai][bj][m][n] = __builtin_amdgcn_mfma_f32_16x16x32_bf16(Bt[n][k], At[m][k], acc[ai][bj][m][n], 0, 0, 0); } \
        __builtin_amdgcn_s_setprio(0); } while (0)
#define PG8_WAIT_V(n) asm volatile("s_waitcnt vmcnt(" #n ")" ::: "memory")
#define PG8_WAIT_L(n) asm volatile("s_waitcnt lgkmcnt(" #n ")" ::: "memory")
#define PG8_BAR __builtin_amdgcn_s_barrier()
#define PG8_SCHED __builtin_amdgcn_sched_barrier(0)
    Unit cur, nxt; int ui = 0;
    if (!S.next(0, cur)) return;
    f32x4 acc[2][2][4][2];
#pragma unroll
    for (int a = 0; a < 2; ++a)
#pragma unroll
        for (int b = 0; b < 2; ++b)
#pragma unroll
            for (int m = 0; m < 4; ++m)
#pragma unroll
                for (int n = 0; n < 2; ++n) acc[a][b][m][n] = (f32x4){0.f, 0.f, 0.f, 0.f};
    int scl = 0x7f7a; asm volatile("" : "+v"(scl));
    bf16x8 At[4][2], B0[2][2], B1[2][2]; v8i_t At8[4], B08[2], B18[2];
    unsigned cA = GATHER ? 0u : (unsigned)cur.pm * tstep; PG8_GOFF(cv0, cv1, 0); unsigned cB = (unsigned)cur.e * (unsigned)g.bstride + (unsigned)cur.pn * tstep;
    S.a_ready(cur);
    if constexpr (SP2) {
        PG8_STAGE(PG8_SB(0, 0), baseB, cB, voffB); PG8_STAGE(PG8_SB(0, 1), baseB, cB + hstep, voffB); PG8_STA(PG8_SA(0, 0), cA, 0, cv0, cv1); PG8_STA(PG8_SA(0, 1), cA, 1, cv0, cv1);
        if (wr == 1) PG8_BAR;
        PG8_WAIT_V(2); PG8_BAR;
        PG8_STAGE(PG8_SB(1, 0), baseB, cB + kstep, voffB); PG8_STA(PG8_SA(1, 0), cA + kstep, 0, cv0, cv1); PG8_STAGE(PG8_SB(1, 1), baseB, cB + hstep + kstep, voffB);
        PG8_WAIT_V(6); PG8_BAR;
    } else {
        PG8_STAGE(PG8_SB(0, 0), baseB, cB, voffB); PG8_STA(PG8_SA(0, 0), cA, 0, cv0, cv1); PG8_STAGE(PG8_SB(0, 1), baseB, cB + hstep, voffB); PG8_STA(PG8_SA(0, 1), cA, 1, cv0, cv1);
        if (wr == 1) PG8_BAR;
        PG8_WAIT_V(4); PG8_BAR;
        PG8_STAGE(PG8_SB(1, 0), baseB, cB + kstep, voffB); PG8_STA(PG8_SA(1, 0), cA + kstep, 0, cv0, cv1); PG8_STAGE(PG8_SB(1, 1), baseB, cB + hstep + kstep, voffB);
        PG8_WAIT_V(6); PG8_BAR;
    }
    for (;;) {
        const bool has_next = S.next(ui + 1, nxt);
        const unsigned nA = (has_next && !GATHER) ? (unsigned)nxt.pm * tstep : cA; if (has_next) { PG8_GOFF(nv0, nv1, ui + 1); } else { _Pragma("unroll") for (int _i = 0; _i < 2; ++_i) { nv0[_i] = cv0[_i]; nv1[_i] = cv1[_i]; } } const unsigned nB = has_next ? (unsigned)nxt.e * (unsigned)g.bstride + (unsigned)nxt.pn * tstep : cB;
        for (int t = 0; t < nt; t += 2) {
            const bool last = (t == nt - 2);
            const unsigned a1 = cA + (unsigned)(t + 1) * kstep;
            const unsigned a2 = last ? nA : cA + (unsigned)(t + 2) * kstep; const unsigned b2 = last ? nB : cB + (unsigned)(t + 2) * kstep;
            const unsigned a3 = a2 + kstep; const unsigned b3 = b2 + kstep;
            unsigned xA0[2], xA1[2];
#pragma unroll
            for (int _i = 0; _i < 2; ++_i) { xA0[_i] = (GATHER && last) ? nv0[_i] : cv0[_i]; xA1[_i] = (GATHER && last) ? nv1[_i] : cv1[_i]; }
            if (last && has_next) S.a_ready(nxt);
            if constexpr (SP2) {
            PG8_LDB(B0, 0, 0); PG8_LDB(B1, 0, 1); PG8_SCHED; PG8_LDA(At, 0, 0); PG8_STA(PG8_SA(1, 1), a1, 1, cv0, cv1);
            PG8_WAIT_V(8); PG8_WAIT_L(0); PG8_BAR; PG8_MMA(0, 0, At, B0); PG8_MMA(0, 1, At, B1); PG8_BAR; PG8_SCHED;
            PG8_LDA(At, 0, 1); PG8_STAGE(PG8_SB(0, 0), baseB, b2, voffB); PG8_STAGE(PG8_SB(0, 1), baseB, b2 + hstep, voffB); PG8_STA(PG8_SA(0, 0), a2, 0, xA0, xA1);
            PG8_WAIT_V(8); PG8_WAIT_L(0); PG8_BAR; PG8_MMA(1, 0, At, B0); PG8_MMA(1, 1, At, B1); PG8_BAR; PG8_SCHED;
            PG8_LDB(B0, 1, 0); PG8_LDB(B1, 1, 1); PG8_SCHED; PG8_LDA(At, 1, 0); PG8_STA(PG8_SA(0, 1), a2, 1, xA0, xA1);
            PG8_WAIT_V(8); PG8_WAIT_L(0); PG8_BAR; PG8_MMA(0, 0, At, B0); PG8_MMA(0, 1, At, B1); PG8_BAR; PG8_SCHED;
            PG8_LDA(At, 1, 1); PG8_STAGE(PG8_SB(1, 0), baseB, b3, voffB); PG8_STAGE(PG8_SB(1, 1), baseB, b3 + hstep, voffB); PG8_STA(PG8_SA(1, 0), a3, 0, xA0, xA1);
            PG8_WAIT_V(8); PG8_WAIT_L(0); PG8_BAR; PG8_MMA(1, 0, At, B0); PG8_MMA(1, 1, At, B1); PG8_BAR; PG8_SCHED;
            } else {
            PG8_LDB(B0, 0, 0); PG8_SCHED; PG8_LDA(At, 0, 0); PG8_STA(PG8_SA(1, 1), a1, 1, cv0, cv1);
            PG8_WAIT_L(8); PG8_BAR; PG8_WAIT_L(0); PG8_MMA(0, 0, At, B0); PG8_BAR; PG8_SCHED;
            PG8_LDB(B1, 0, 1); PG8_STAGE(PG8_SB(0, 0), baseB, b2, voffB);
            PG8_BAR; PG8_WAIT_L(0); PG8_MMA(0, 1, At, B1); PG8_BAR;
            PG8_LDA(At, 0, 1); PG8_STA(PG8_SA(0, 0), a2, 0, xA0, xA1);
            PG8_BAR; PG8_WAIT_L(0); PG8_MMA(1, 0, At, B0); PG8_BAR; PG8_SCHED;
            PG8_STAGE(PG8_SB(0, 1), baseB, b2 + hstep, voffB);
            PG8_WAIT_V(6); PG8_BAR; PG8_MMA(1, 1, At, B1); PG8_BAR;
            PG8_LDB(B0, 1, 0); PG8_SCHED; PG8_LDA(At, 1, 0); PG8_STA(PG8_SA(0, 1), a2, 1, xA0, xA1);
            PG8_WAIT_L(8); PG8_BAR; PG8_WAIT_L(0); PG8_MMA(0, 0, At, B0); PG8_BAR; PG8_SCHED;
            PG8_LDB(B1, 1, 1); PG8_STAGE(PG8_SB(1, 0), baseB, b3, voffB);
            PG8_BAR; PG8_WAIT_L(0); PG8_MMA(0, 1, At, B1); PG8_BAR;
            PG8_LDA(At, 1, 1); PG8_STA(PG8_SA(1, 0), a3, 0, xA0, xA1);
            PG8_BAR; PG8_WAIT_L(0); PG8_MMA(1, 0, At, B0); PG8_BAR; PG8_SCHED;
            PG8_STAGE(PG8_SB(1, 1), baseB, b3 + hstep, voffB);
            PG8_WAIT_V(6); PG8_BAR; PG8_MMA(1, 1, At, B1); PG8_BAR;
            }
        }
        if constexpr (ALIGN_EPI) { if (wr == 0) PG8_BAR; }
        if constexpr (!Epi::AFTER_DRAIN) { int l2; asm volatile("v_mbcnt_lo_u32_b32 %0, -1, 0\n\tv_mbcnt_hi_u32_b32 %0, -1, %0" : "=v"(l2)); E(acc, cur, wr, wc, l2 & 15, l2 >> 4); S.done(cur); }
        if (!has_next) break;
#pragma unroll
        for (int a = 0; a < 2; ++a)
#pragma unroll
            for (int b = 0; b < 2; ++b)
#pragma unroll
                for (int m = 0; m < 4; ++m)
#pragma unroll
                    for (int n = 0; n < 2; ++n) acc[a][b][m][n] = (f32x4){0.f, 0.f, 0.f, 0.f};
        cur = nxt; cA = nA; cB = nB; ++ui;
#pragma unroll
        for (int _i = 0; _i < 2; ++_i) { cv0[_i] = nv0[_i]; cv1[_i] = nv1[_i]; }
        if constexpr (ALIGN_EPI) { if (wr == 1) PG8_BAR; }
    }
    PG8_WAIT_V(0);
    if constexpr (!ALIGN_EPI) { if (wr == 0) PG8_BAR; }
    PG8_BAR;
    if constexpr (Epi::AFTER_DRAIN) { E.fused(acc, cur, wr, wc, fr, fq, lds, wid, lane); S.done(cur); }
#undef PG8_SA
#undef PG8_SB
#undef PG8_STAGE
#undef PG8_STA
#undef PG8_GOFF
#undef PG8_LDA
#undef PG8_LDB
#undef PG8_MMA
#undef PG8_RD8
#undef PG8_WAIT_V
#undef PG8_WAIT_L
#undef PG8_BAR
#undef PG8_SCHED
}
}

constexpr int NWAVES = 8;
#ifndef MK_ONE_LAUNCH
#define MK_ONE_LAUNCH 1
#endif
#ifndef MK_ATTN_NAIVE
#define MK_ATTN_NAIVE 0
#endif
constexpr int N_PHASES = 9;

constexpr int BATCH = 32, SEQ = 2048, D = 1024, T = BATCH * SEQ;
constexpr int NQKV = 2304, C_DQ = 0, C_DK = 512, C_DV = 1024, C_SQ = 1536, C_SK = 2048, C_SV = 2176;
constexpr int NEXP = 16, DEXP = 512;
constexpr int SORT_ROWS = 2 * T + NEXP * 256;
constexpr float EPS = 1e-6f;

constexpr size_t MiB = 1u << 20;
constexpr size_t WS_CTL = 0, CTL_ZERO_BYTES = 1 * MiB;
constexpr size_t WS_MOD = 1 * MiB;
constexpr size_t WS_ROPE = 2 * MiB;
constexpr size_t WS_TOK = 3 * MiB;
constexpr size_t WS_LIST = 5 * MiB;
constexpr size_t WS_WIN = 10 * MiB;
constexpr size_t WS_WO = 15 * MiB;
constexpr size_t WS_WGU = 17 * MiB;
constexpr size_t WS_WD = 49 * MiB;
constexpr size_t WS_ACT = 66 * MiB;
constexpr size_t WS_QKV = 194 * MiB;
constexpr size_t WS_GU = 482 * MiB;
constexpr size_t WS_ACTM = 746 * MiB;
constexpr size_t WS_END = 878 * MiB;
static_assert(WS_QKV + (size_t)T * NQKV * 2 <= WS_GU && WS_QKV + (size_t)SORT_ROWS * 1024 * 2 <= WS_GU && WS_GU + (size_t)SORT_ROWS * 1024 * 2 <= WS_ACTM && WS_GU + (size_t)T * 1024 * 4 <= WS_ACTM && WS_ACTM + (size_t)SORT_ROWS * 512 * 2 <= WS_END, "ws map");
constexpr int CW_CNT = 64;
constexpr int CW_BAR = 4096;

constexpr int RING_BYTES = 131072;
constexpr int MISC_OFF = RING_BYTES + 320;
constexpr int LDS_BYTES = 147456;

#define GAS __attribute__((address_space(1)))
#define LAS __attribute__((address_space(3)))
typedef unsigned short bf16;
typedef unsigned v4u __attribute__((ext_vector_type(4)));
typedef unsigned v2u __attribute__((ext_vector_type(2)));
typedef float f32x4 __attribute__((ext_vector_type(4)));
typedef float f32x2v __attribute__((ext_vector_type(2)));
#define RLX_AGENT __ATOMIC_RELAXED, __HIP_MEMORY_SCOPE_AGENT
#define LDS_WAIT() asm volatile("s_waitcnt lgkmcnt(0)" ::: "memory")
__device__ __forceinline__ unsigned f2bf(float f) { unsigned u = __builtin_bit_cast(unsigned, f); return (u + 0x7fffu + ((u >> 16) & 1u)) >> 16; }
__device__ __forceinline__ unsigned pk2(float lo, float hi) { return f2bf(lo) | (f2bf(hi) << 16); }
__device__ __forceinline__ float bflo(unsigned w) { return __builtin_bit_cast(float, w << 16); }
__device__ __forceinline__ float bfhi(unsigned w) { return __builtin_bit_cast(float, w & 0xffff0000u); }
__device__ __forceinline__ float wave_sum(float v) {
#pragma unroll
    for (int o = 1; o < 64; o <<= 1) v += __shfl_xor(v, o);
    return v;
}

#define XB_TMO      128
#define XB_XCNT(j)  (256  + 64 * (j))
#define XB_XSUB(j)  (1280 + 64 * (j))
#define XB_XGEN(j)  (2304 + 64 * (j))
#define XB_TOP      3328
#define XB_TOPGEN   3392
#define XCD_BAR_WORDS 3456
#define XB_SPIN_CAP (1u << 18)

__device__ __forceinline__ unsigned xb_ld(unsigned* p)              { return __hip_atomic_load(p, __ATOMIC_RELAXED, __HIP_MEMORY_SCOPE_AGENT); }
__device__ __forceinline__ unsigned xb_add(unsigned* p, unsigned v) { return __hip_atomic_fetch_add(p, v, __ATOMIC_RELAXED, __HIP_MEMORY_SCOPE_AGENT); }
__device__ __forceinline__ unsigned xb_xcc_id() { return (unsigned)__builtin_amdgcn_s_getreg((3 << 11) | 20) & 0xFu; }
#define XB_SPIN(cond, bar) do { unsigned _sp = 0; while (cond) { __builtin_amdgcn_s_sleep(1); \
    if ((++_sp & 255u) == 0u) { if (xb_ld(&(bar)[XB_TMO])) break; if (_sp > XB_SPIN_CAP) { atomicAdd(&(bar)[XB_TMO], 1u); break; } } } } while (0)

struct XcdBarrier {
    unsigned* bar; unsigned x;
    volatile LAS unsigned* st;
};

__device__ __forceinline__ XcdBarrier xcd_barrier_post(unsigned* bar, volatile LAS unsigned* st) {
    XcdBarrier b; b.bar = bar; b.x = xb_xcc_id(); b.st = st;
    if (threadIdx.x == 0) (void)xb_add(&bar[XB_XCNT(b.x)], 1u);
    return b;
}
__device__ __forceinline__ void xcd_barrier_complete(unsigned* bar, unsigned x, unsigned& nloc, unsigned& nx) {
    const unsigned G = gridDim.x * gridDim.y * gridDim.z;
    unsigned sum, cnt, mine, sp = 0u;
    for (;;) {
        sum = 0u; cnt = 0u; mine = 0u;
#pragma unroll
        for (unsigned j = 0; j < 16; ++j) { const unsigned c = xb_ld(&bar[XB_XCNT(j)]); sum += c; cnt += (c > 0u) ? 1u : 0u; mine = (j == x) ? c : mine; }
        if (sum == G) break;
        __builtin_amdgcn_s_sleep(1);
        if ((++sp & 255u) == 0u) { if (xb_ld(&bar[XB_TMO])) break; if (sp > XB_SPIN_CAP) { atomicAdd(&bar[XB_TMO], 1u); break; } }
    }
    nloc = mine > 0u ? mine : 1u; nx = cnt > 0u ? cnt : 1u;
}

__device__ __forceinline__ void xcd_barrier(const XcdBarrier& b) {
    asm volatile("s_waitcnt vmcnt(0)" ::: "memory");
    __syncthreads();
    if (threadIdx.x == 0) {
        unsigned* bar = b.bar;
        __builtin_amdgcn_s_waitcnt(0);
        unsigned nloc = b.st[0], nx = b.st[1];
        if (nloc == 0u) { xcd_barrier_complete(bar, b.x, nloc, nx); b.st[0] = nloc; b.st[1] = nx; }
        const unsigned old = xb_add(&bar[XB_XSUB(b.x)], 1u);
        const unsigned gen = old / nloc;
        if (old + 1u == (gen + 1u) * nloc) {
            __builtin_amdgcn_fence(__ATOMIC_RELEASE, "agent");
            asm volatile("s_waitcnt vmcnt(0)" ::: "memory");
            const unsigned og = xb_add(&bar[XB_TOP], 1u);
            const unsigned tg = og / nx;
            if (og + 1u == (tg + 1u) * nx) xb_add(&bar[XB_TOPGEN], 1u);
            else XB_SPIN(xb_ld(&bar[XB_TOPGEN]) == tg, bar);
            __builtin_amdgcn_fence(__ATOMIC_ACQUIRE, "agent");
            xb_add(&bar[XB_XGEN(b.x)], 1u);
            asm volatile("s_waitcnt vmcnt(0)" ::: "memory");
        } else {
            XB_SPIN(xb_ld(&bar[XB_XGEN(b.x)]) == gen, bar);
            __builtin_amdgcn_fence(__ATOMIC_ACQUIRE, "agent");
            asm volatile("s_waitcnt vmcnt(0)" ::: "memory");
        }
    }
    __syncthreads();
}


__device__ __forceinline__ int fresh_lane() { int l; asm volatile("v_mbcnt_lo_u32_b32 %0, -1, 0\n\tv_mbcnt_hi_u32_b32 %0, -1, %0" : "=v"(l)); return l; }
struct Frame {
    LAS unsigned char* lds;
    unsigned* ctl;
    int tid, lane, wave, G, bid;
    const float *x, *c, *w_ada, *b_ada, *g_mix, *w_in, *diff_lambda, *g_diff_sub, *swa_sinks, *w_out, *g_ffn, *w_rg, *b_rg, *w_re, *b_re, *w_gate, *w_up, *w_down, *g_final;
    float* out; unsigned char* ws;
    float* mod; float* rope;
    int *tok_e, *tok_r0, *tok_r1; float *tok_w0, *tok_w1; int* list;
    bf16 *WinT, *WoT, *ACT, *QKV, *X1; unsigned char *WguT, *WdT, *H8, *ACTM, *Y;
};

__device__ __forceinline__ int dst_row(int mode, int c) {
    if (mode == 1) { if (c < 1024 || (c >= 1536 && c < 2176)) { const int d = c & 63; return (c & ~63) + 32 * ((d >> 4) & 1) + 8 * ((d >> 2) & 3) + 4 * (d >> 5) + (d & 3); } return c; }
    if (mode >= 2) return 256 * (c >> 7) + 128 * ((c >> 6) & 1) + 32 * ((c >> 4) & 3) + 8 * ((c >> 2) & 3) + 4 * (mode - 2) + (c & 3);
    return c;
}
__device__ __forceinline__ void p0_transpose_item(const float* W, int K, int N, bf16* WT, int mode, LAS float* scr, int item, int lane) {
    const int nblk = N / 32, kb = item / nblk, nb = item % nblk, k0 = 64 * kb, n0 = 32 * nb;
#pragma unroll
    for (int i = 0; i < 32; ++i) { const int kk = 2 * i + (lane >> 5); scr[kk * 33 + (lane & 31)] = W[(size_t)(k0 + kk) * N + n0 + (lane & 31)]; }
    LDS_WAIT(); asm volatile("" ::: "memory");
    const int c = lane & 7;
#pragma unroll
    for (int j = 0; j < 4; ++j) { const int n = (lane >> 3) + 8 * j; const LAS float* s = scr + (8 * c) * 33 + n;
        v4u o; o.x = pk2(s[0 * 33], s[1 * 33]); o.y = pk2(s[2 * 33], s[3 * 33]); o.z = pk2(s[4 * 33], s[5 * 33]); o.w = pk2(s[6 * 33], s[7 * 33]);
        *(v4u*)(WT + (size_t)dst_row(mode, n0 + n) * K + k0 + 8 * c) = o; }
    LDS_WAIT(); asm volatile("" ::: "memory");
}

__device__ __forceinline__ void p0_transpose_item8(const float* W, int K, int N, unsigned char* WT, int mode, LAS float* scr, int item, int lane) {
    const int nblk = N / 32, kb = item / nblk, nb = item % nblk, k0 = 64 * kb, n0 = 32 * nb;
#pragma unroll
    for (int i = 0; i < 32; ++i) { const int kk = 2 * i + (lane >> 5); scr[kk * 33 + (lane & 31)] = W[(size_t)(k0 + kk) * N + n0 + (lane & 31)] * 32.f; }
    LDS_WAIT(); asm volatile("" ::: "memory");
#pragma unroll
    for (int j = 0; j < 2; ++j) { const int idx = lane + 64 * j, n = idx >> 2, c = idx & 3; const LAS float* s = scr + (16 * c) * 33 + n;
        int w[4];
#pragma unroll
        for (int q = 0; q < 4; ++q) { int t = 0; t = __builtin_amdgcn_cvt_pk_fp8_f32(s[(4 * q) * 33], s[(4 * q + 1) * 33], t, false); t = __builtin_amdgcn_cvt_pk_fp8_f32(s[(4 * q + 2) * 33], s[(4 * q + 3) * 33], t, true); w[q] = t; }
        *(v4u*)(WT + (size_t)dst_row(mode, n0 + n) * K + k0 + 16 * c) = (v4u){(unsigned)w[0], (unsigned)w[1], (unsigned)w[2], (unsigned)w[3]}; }
    LDS_WAIT(); asm volatile("" ::: "memory");
}

__device__ __forceinline__ void ph_prologue(Frame& F) {
    const int gw = F.bid * NWAVES + F.wave, NGW = F.G * NWAVES;
    {
        typedef float f32x2 __attribute__((ext_vector_type(2)));
        const int g = F.tid >> 4, l = F.tid & 15;
        LAS float* ca = (LAS float*)F.lds;
        for (int cb = F.bid; cb < 256; cb += F.G) {
            const int j0 = cb * 24;
            const __amdgpu_buffer_rsrc_t wr = __builtin_amdgcn_make_buffer_rsrc((void*)F.w_ada, 0, 1024 * 6144 * 4, 0x00020000);
            const int voff = ((32 * g) * 6144 + j0 + 2 * (l < 12 ? l : 0)) * 4;
            f32x2 wn[8];
#pragma unroll
            for (int kk = 0; kk < 8; ++kk) wn[kk] = __builtin_bit_cast(f32x2, __builtin_amdgcn_raw_buffer_load_b64(wr, voff, kk * 24576, 0));
#pragma unroll 4
            for (int it = 0; it < 16; ++it) { const int idx = it * 512 + F.tid, kk = idx & 1023, b4 = idx >> 10;
                f32x4 v; const float* cp = F.c + (size_t)(4 * b4) * 1024 + kk;
                v.x = cp[0]; v.y = cp[1024]; v.z = cp[2048]; v.w = cp[3072];
                v.x = v.x / (1.f + __expf(-v.x)); v.y = v.y / (1.f + __expf(-v.y)); v.z = v.z / (1.f + __expf(-v.z)); v.w = v.w / (1.f + __expf(-v.w));
                *(LAS f32x4*)(ca + kk * 32 + ((b4 ^ ((kk ^ (kk >> 5)) & 7)) << 2)) = v; }
            __syncthreads();
            f32x2 acc[32];
#pragma unroll
            for (int b = 0; b < 32; ++b) acc[b] = (f32x2){0.f, 0.f};
            const LAS float* bc[8];
#pragma unroll
            for (int c = 0; c < 8; ++c) bc[c] = ca + g * 1024 + ((c ^ (g & 7)) << 2);
#pragma unroll 1
            for (int ch = 0; ch < 4; ++ch) {
                f32x2 w[8];
#pragma unroll
                for (int kk = 0; kk < 8; ++kk) w[kk] = wn[kk];
                if (ch < 3) {
#pragma unroll
                    for (int kk = 0; kk < 8; ++kk) wn[kk] = __builtin_bit_cast(f32x2, __builtin_amdgcn_raw_buffer_load_b64(wr, voff, (ch + 1) * (8 * 24576) + kk * 24576, 0)); }
#pragma unroll
                for (int kk = 0; kk < 8; ++kk) {
#pragma unroll
                    for (int b4 = 0; b4 < 8; ++b4) { const f32x4 cv = *(const LAS f32x4*)(bc[b4 ^ kk] + (ch * 8 + kk) * 32);
                        acc[b4 * 4 + 0] = __builtin_elementwise_fma((f32x2){cv.x, cv.x}, w[kk], acc[b4 * 4 + 0]); acc[b4 * 4 + 1] = __builtin_elementwise_fma((f32x2){cv.y, cv.y}, w[kk], acc[b4 * 4 + 1]);
                        acc[b4 * 4 + 2] = __builtin_elementwise_fma((f32x2){cv.z, cv.z}, w[kk], acc[b4 * 4 + 2]); acc[b4 * 4 + 3] = __builtin_elementwise_fma((f32x2){cv.w, cv.w}, w[kk], acc[b4 * 4 + 3]); } }
            }
            __syncthreads();
            LAS float* red = (LAS float*)F.lds;
            if (l < 12) {
#pragma unroll
                for (int b = 0; b < 32; ++b) *(LAS f32x2*)(red + (g * 32 + b) * 24 + 2 * l) = acc[b]; }
            __syncthreads();
            for (int o = F.tid; o < 768; o += NWAVES * 64) { const int b = o / 24, jj = o - b * 24; float s = 0.f;
#pragma unroll
                for (int gg = 0; gg < 32; ++gg) s += red[(gg * 32 + b) * 24 + jj];
                F.mod[b * 6144 + j0 + jj] = s + F.b_ada[j0 + jj]; }
            __syncthreads();
        }
    }
    for (int i = F.bid * NWAVES * 64 + F.tid; i < SEQ * 32; i += F.G * NWAVES * 64) {
        const int pos = i >> 5, f = i & 31; const float inv = exp2f(-(float)f * (13.287712379549449f / 32.f)); const float ang = (float)pos * inv;
        F.rope[i] = cosf(ang); F.rope[SEQ * 32 + i] = sinf(ang); }
    LAS float* scr = (LAS float*)(F.lds + F.wave * 16384);
    constexpr int I_IN = 16 * 72, I_O = 16 * 32;
    for (int it = gw; it < I_IN + I_O; it += NGW) {
        if (it < I_IN) p0_transpose_item(F.w_in, 1024, NQKV, F.WinT, 1, scr, it, F.lane);
        else p0_transpose_item(F.w_out, 1024, 1024, F.WoT, 0, scr, it - I_IN, F.lane);
    }
}
__device__ __forceinline__ void expert_items(Frame& F, int k0, int k1) {
    const int gw = F.bid * NWAVES + F.wave, NGW = F.G * NWAVES;
    LAS float* scr = (LAS float*)(F.lds + F.wave * 16384);
    constexpr int I_G = 16 * 16 * 16, I_D = 16 * 8 * 32;
    for (int k = k0; k < k1; ++k) {
        int r = gw + k * NGW; if (r >= 2 * I_G + I_D) break;
        if (r < I_G) { const int e = r >> 8; p0_transpose_item8(F.w_gate + (size_t)e * 1024 * 512, 1024, 512, F.WguT + (size_t)e * 1024 * 1024, 2, scr, r & 255, F.lane); continue; } r -= I_G;
        if (r < I_G) { const int e = r >> 8; p0_transpose_item8(F.w_up + (size_t)e * 1024 * 512, 1024, 512, F.WguT + (size_t)e * 1024 * 1024, 3, scr, r & 255, F.lane); continue; } r -= I_G;
        { const int e = r >> 8; p0_transpose_item8(F.w_down + (size_t)e * 512 * 1024, 512, 1024, F.WdT + (size_t)e * 1024 * 512, 0, scr, r & 255, F.lane); }
    }
}

__device__ __forceinline__ void ph_norm1(Frame& F) {
    const int gw = F.bid * NWAVES + F.wave, NGW = F.G * NWAVES;
    for (int m0 = gw * 4; m0 < T; m0 += NGW * 4) {
        const int b = m0 >> 11;
        f32x4 v[4][4]; float s[4];
#pragma unroll
        for (int r = 0; r < 4; ++r) { const f32x4* xr = (const f32x4*)(F.x + (size_t)(m0 + r) * D) + F.lane;
#pragma unroll
            for (int j = 0; j < 4; ++j) v[r][j] = xr[64 * j]; }
#pragma unroll
        for (int r = 0; r < 4; ++r) { float a = 0.f;
#pragma unroll
            for (int j = 0; j < 4; ++j) a += (v[r][j].x * v[r][j].x + v[r][j].y * v[r][j].y) + (v[r][j].z * v[r][j].z + v[r][j].w * v[r][j].w);
            s[r] = 1.f / sqrtf(wave_sum(a) * (1.f / D) + EPS); }
        const float* mb = F.mod + b * 6144;
#pragma unroll
        for (int j = 0; j < 4; ++j) { const int col = F.lane * 4 + 256 * j;
            const f32x4 g = *(const f32x4*)(F.g_mix + col), sh = *(const f32x4*)(mb + col), sc = *(const f32x4*)(mb + 1024 + col);
            const f32x4 gs = g * (sc + 1.f);
#pragma unroll
            for (int r = 0; r < 4; ++r) { const f32x4 a = v[r][j] * s[r] * gs + sh;
                *((unsigned long long*)(F.ACT + (size_t)(m0 + r) * D) + F.lane + 64 * j) = (unsigned long long)pk2(a.x, a.y) | ((unsigned long long)pk2(a.z, a.w) << 32); } }
    }
}

__device__ __forceinline__ float diff_lambda_value(Frame& F) {
    const float a = F.diff_lambda[F.lane] * F.diff_lambda[64 + F.lane], b = F.diff_lambda[128 + F.lane] * F.diff_lambda[192 + F.lane];
    return __expf(wave_sum(a)) - __expf(wave_sum(b)) + 0.2f;
}
template <int CTRL> __device__ __forceinline__ float dpp_add(float v) { return v + __builtin_bit_cast(float, __builtin_amdgcn_update_dpp(0, __builtin_bit_cast(int, v), CTRL, 0xf, 0xf, true)); }
__device__ __forceinline__ float wave_allsum(float v) {
    v = dpp_add<0xB1>(v); v = dpp_add<0x4E>(v); v = dpp_add<0x141>(v); v = dpp_add<0x140>(v);
    { const unsigned u = __float_as_uint(v); auto rr = __builtin_amdgcn_permlane16_swap(u, u, false, false); v = __uint_as_float(rr[0]) + __uint_as_float(rr[1]); }
    { const unsigned u = __float_as_uint(v); auto rr = __builtin_amdgcn_permlane32_swap(u, u, false, false); v = __uint_as_float(rr[0]) + __uint_as_float(rr[1]); }
    return v;
}
__device__ __forceinline__ float hsum4(f32x4 a) { return (a.x + a.y) + (a.z + a.w); }
__device__ __forceinline__ void ph_norm2_route(Frame& F) {
    LAS float* WrT = (LAS float*)F.lds;
    LAS int* rinfo = (LAS int*)(F.lds + 81920);
    LAS int* hist = (LAS int*)(F.lds + 81920 + 4096);
    for (int k = F.tid; k < 1024; k += NWAVES * 64) {
        const f32x4 g = *(const f32x4*)(F.w_rg + k * 4);
        WrT[0 * 1024 + k] = g.x; WrT[1 * 1024 + k] = g.y; WrT[2 * 1024 + k] = g.z; WrT[3 * 1024 + k] = g.w;
#pragma unroll
        for (int q = 0; q < 4; ++q) { const f32x4 e = *(const f32x4*)(F.w_re + k * 16 + 4 * q);
            WrT[(4 + 4 * q) * 1024 + k] = e.x; WrT[(5 + 4 * q) * 1024 + k] = e.y; WrT[(6 + 4 * q) * 1024 + k] = e.z; WrT[(7 + 4 * q) * 1024 + k] = e.w; }
    }
    const f32x4 brg = *(const f32x4*)F.b_rg;
    for (int chunk = F.bid; chunk < T / 256; chunk += F.G) {
        if (F.tid < 32) hist[F.tid] = 0;
        __syncthreads();
        const int b = (chunk * 256) >> 11; const float* mb = F.mod + b * 6144;
        unsigned long long xq[4][4];
#pragma unroll
        for (int r = 0; r < 4; ++r) { const unsigned long long* xr = (const unsigned long long*)(F.X1 + (size_t)(chunk * 256 + F.wave * 32 + r) * D) + F.lane;
#pragma unroll
            for (int j = 0; j < 4; ++j) xq[r][j] = xr[64 * j]; }
        for (int rr = 0; rr < 32; rr += 4) {
            const int lt0 = F.wave * 32 + rr, m0 = chunk * 256 + lt0;
            f32x4 v[4][4]; float rs[4];
#pragma unroll
            for (int r = 0; r < 4; ++r)
#pragma unroll
                for (int j = 0; j < 4; ++j) { const unsigned long long w = xq[r][j]; const unsigned lo = (unsigned)w, hi = (unsigned)(w >> 32); v[r][j] = (f32x4){bflo(lo), bfhi(lo), bflo(hi), bfhi(hi)}; }
            if (rr + 4 < 32) {
#pragma unroll
                for (int r = 0; r < 4; ++r) { const unsigned long long* xr = (const unsigned long long*)(F.X1 + (size_t)(m0 + 4 + r) * D) + F.lane;
#pragma unroll
                    for (int j = 0; j < 4; ++j) xq[r][j] = xr[64 * j]; } }
#pragma unroll
            for (int r = 0; r < 4; ++r) { f32x4 a = v[r][0] * v[r][0];
#pragma unroll
                for (int j = 1; j < 4; ++j) a += v[r][j] * v[r][j];
                rs[r] = 1.f / sqrtf(wave_allsum(hsum4(a)) * (1.f / D) + EPS); }
#pragma unroll
            for (int j = 0; j < 4; ++j) { const int col = F.lane * 4 + 256 * j;
                const f32x4 g = *(const f32x4*)(F.g_ffn + col), sh = *(const f32x4*)(mb + 3072 + col), sc = *(const f32x4*)(mb + 4096 + col);
                const f32x4 gs = g * (sc + 1.f);
#pragma unroll
                for (int r = 0; r < 4; ++r) { v[r][j] = v[r][j] * rs[r] * gs + sh;
                    const f32x4 hc = __builtin_elementwise_min(__builtin_elementwise_max(v[r][j], (f32x4){-448.f, -448.f, -448.f, -448.f}), (f32x4){448.f, 448.f, 448.f, 448.f});
                    int w8 = 0; w8 = __builtin_amdgcn_cvt_pk_fp8_f32(hc.x, hc.y, w8, false); w8 = __builtin_amdgcn_cvt_pk_fp8_f32(hc.z, hc.w, w8, true);
                    *((int*)(F.H8 + (size_t)(m0 + r) * D) + F.lane + 64 * j) = w8; } }
            float gl[4][4];
#pragma unroll
            for (int c = 0; c < 4; ++c) { f32x4 a[4];
#pragma unroll
                for (int j = 0; j < 4; ++j) { const f32x4 w = *(const LAS f32x4*)(WrT + c * 1024 + F.lane * 4 + 256 * j);
#pragma unroll
                    for (int r = 0; r < 4; ++r) a[r] = (j == 0) ? v[r][j] * w : a[r] + v[r][j] * w; }
#pragma unroll
                for (int r = 0; r < 4; ++r) gl[r][c] = wave_allsum(hsum4(a[r])) + brg[c]; }
#pragma unroll
            for (int r = 0; r < 4; ++r) {
                int gi = 0; float gm = gl[r][0];
#pragma unroll
                for (int g = 1; g < 4; ++g) if (gl[r][g] > gm) { gm = gl[r][g]; gi = g; }
                gi = __builtin_amdgcn_readfirstlane(gi);
                float gsum = 0.f;
#pragma unroll
                for (int g = 0; g < 4; ++g) gsum += __expf(gl[r][g] - gm);
                const float grp_p = 1.f / gsum;
                const LAS float* We = WrT + (4 + 4 * gi) * 1024 + F.lane * 4;
                f32x4 ea[4];
#pragma unroll
                for (int j = 0; j < 4; ++j)
#pragma unroll
                    for (int i = 0; i < 4; ++i) { const f32x4 w = *(const LAS f32x4*)(We + i * 1024 + 256 * j); ea[i] = (j == 0) ? v[r][j] * w : ea[i] + v[r][j] * w; }
                const f32x4 bre = *(const f32x4*)(F.b_re + 4 * gi);
                float el[4];
#pragma unroll
                for (int i = 0; i < 4; ++i) el[i] = wave_allsum(hsum4(ea[i])) + bre[i];
                int i0 = 0; float m0v = el[0];
#pragma unroll
                for (int i = 1; i < 4; ++i) if (el[i] > m0v) { m0v = el[i]; i0 = i; }
                int i1 = -1; float m1v = -3.0e38f;
#pragma unroll
                for (int i = 0; i < 4; ++i) if (i != i0 && el[i] > m1v) { m1v = el[i]; i1 = i; }
                const float t = __expf(m1v - m0v); const float w0 = grp_p / (1.f + t), w1 = grp_p * t / (1.f + t);
                if (F.lane == 0) { const int lt = lt0 + r; rinfo[lt * 4 + 0] = gi * 4 + i0; rinfo[lt * 4 + 1] = gi * 4 + i1; rinfo[lt * 4 + 2] = __builtin_bit_cast(int, w0); rinfo[lt * 4 + 3] = __builtin_bit_cast(int, w1); }
            }
        }
        __syncthreads();
        int e0 = 0, e1 = 0, r0 = 0, r1 = 0;
        if (F.tid < 256) { e0 = rinfo[F.tid * 4]; e1 = rinfo[F.tid * 4 + 1]; r0 = __hip_atomic_fetch_add(&hist[e0], 1, __ATOMIC_RELAXED, __HIP_MEMORY_SCOPE_WORKGROUP); r1 = __hip_atomic_fetch_add(&hist[e1], 1, __ATOMIC_RELAXED, __HIP_MEMORY_SCOPE_WORKGROUP); }
        __syncthreads();
        if (F.tid < 16) hist[16 + F.tid] = (int)__hip_atomic_fetch_add(F.ctl + CW_CNT + F.tid, (unsigned)hist[F.tid], RLX_AGENT);
        __syncthreads();
        if (F.tid < 256) { const int m = chunk * 256 + F.tid; r0 += hist[16 + e0]; r1 += hist[16 + e1];
            F.list[e0 * T + r0] = m; F.list[e1 * T + r1] = m;
            F.tok_e[m] = e0 | (e1 << 8); F.tok_r0[m] = r0; F.tok_r1[m] = r1; F.tok_w0[m] = __builtin_bit_cast(float, rinfo[F.tid * 4 + 2]); F.tok_w1[m] = __builtin_bit_cast(float, rinfo[F.tid * 4 + 3]); }
        __syncthreads();
    }
}

__device__ __forceinline__ void load_tstart(Frame& F, LAS int* ts) {
    if (F.tid == 0) { int acc = 0;
        for (int e = 0; e < 16; ++e) { ts[e] = acc; const int n = (int)__hip_atomic_load(F.ctl + CW_CNT + e, RLX_AGENT); ts[32 + e] = n; acc += (n + 255) >> 8; }
        ts[16] = acc; }
    __syncthreads();
}

__device__ __forceinline__ void ph_final(Frame& F) {
    LAS int* ts = (LAS int*)(F.lds + RING_BYTES);
    load_tstart(F, ts);
    const int gw = F.bid * NWAVES + F.wave, NGW = F.G * NWAVES;
    for (int m0 = gw * 4; m0 < T; m0 += NGW * 4) {
        const int b = m0 >> 11; const float* mb = F.mod + b * 6144;
        const int mr = m0 + (F.lane & 3);
        const int ee = F.tok_e[mr]; const int e0 = ee & 255, e1 = ee >> 8;
        const unsigned q0 = 256u * (unsigned)ts[e0] + (unsigned)F.tok_r0[mr], q1 = 256u * (unsigned)ts[e1] + (unsigned)F.tok_r1[mr];
        const float w0l = F.tok_w0[mr], w1l = F.tok_w1[mr];
        f32x4 v[4][4]; unsigned ya[4][4], yb[4][4]; float w0[4], w1[4];
#pragma unroll
        for (int r = 0; r < 4; ++r) {
            const size_t p0 = (unsigned)__builtin_amdgcn_readlane((int)q0, r), p1 = (unsigned)__builtin_amdgcn_readlane((int)q1, r);
            w0[r] = __builtin_bit_cast(float, __builtin_amdgcn_readlane(__builtin_bit_cast(int, w0l), r)); w1[r] = __builtin_bit_cast(float, __builtin_amdgcn_readlane(__builtin_bit_cast(int, w1l), r));
            const unsigned long long* xr = (const unsigned long long*)(F.X1 + (size_t)(m0 + r) * D) + F.lane;
            const unsigned* y0 = (const unsigned*)(F.Y + p0 * D) + F.lane; const unsigned* y1 = (const unsigned*)(F.Y + p1 * D) + F.lane;
#pragma unroll
            for (int j = 0; j < 4; ++j) { const unsigned long long w = xr[64 * j]; const unsigned lo = (unsigned)w, hi = (unsigned)(w >> 32); v[r][j] = (f32x4){bflo(lo), bfhi(lo), bflo(hi), bfhi(hi)}; ya[r][j] = y0[64 * j]; yb[r][j] = y1[64 * j]; }
        }
        float rs[4];
#pragma unroll
        for (int r = 0; r < 4; ++r) { float s = 0.f;
#pragma unroll
            for (int j = 0; j < 4; ++j) { const int col = F.lane * 4 + 256 * j; const f32x4 gt = *(const f32x4*)(mb + 5120 + col);
                const f32x2v a01 = __builtin_amdgcn_cvt_pk_f32_fp8((int)ya[r][j], false), a23 = __builtin_amdgcn_cvt_pk_f32_fp8((int)ya[r][j], true), c01 = __builtin_amdgcn_cvt_pk_f32_fp8((int)yb[r][j], false), c23 = __builtin_amdgcn_cvt_pk_f32_fp8((int)yb[r][j], true);
                v[r][j].x += gt.x * (w0[r] * a01.x + w1[r] * c01.x); v[r][j].y += gt.y * (w0[r] * a01.y + w1[r] * c01.y); v[r][j].z += gt.z * (w0[r] * a23.x + w1[r] * c23.x); v[r][j].w += gt.w * (w0[r] * a23.y + w1[r] * c23.y);
                s += (v[r][j].x * v[r][j].x + v[r][j].y * v[r][j].y) + (v[r][j].z * v[r][j].z + v[r][j].w * v[r][j].w); }
            rs[r] = 1.f / sqrtf(wave_sum(s) * (1.f / D) + EPS); }
#pragma unroll
        for (int j = 0; j < 4; ++j) { const int col = F.lane * 4 + 256 * j; const f32x4 g = *(const f32x4*)(F.g_final + col);
#pragma unroll
            for (int r = 0; r < 4; ++r) *((f32x4*)(F.out + (size_t)(m0 + r) * D) + F.lane + 64 * j) = v[r][j] * rs[r] * g; }
    }
}


namespace fa {
typedef short bf16x8 __attribute__((ext_vector_type(8)));
typedef short s16x4 __attribute__((ext_vector_type(4)));
typedef short v4i16_t __attribute__((ext_vector_type(4)));
typedef float f32x16 __attribute__((ext_vector_type(16)));
typedef float f32x2_t __attribute__((ext_vector_type(2))); typedef __bf16 bf16x2_t __attribute__((ext_vector_type(2)));
typedef LAS const char* lds_cptr;
constexpr float LOG2E = 1.4426950408889634f;
constexpr float QSCALE = 0.125f * LOG2E;
#define FA_THR 8.0f
__device__ __forceinline__ int crow(int r, int hi) { return (r & 3) + 8 * (r >> 2) + 4 * hi; }
__device__ __forceinline__ unsigned cvtpk(float lo, float hi) { f32x2_t v = {lo, hi}; bf16x2_t b = __builtin_convertvector(v, bf16x2_t); return __builtin_bit_cast(unsigned, b); }
__device__ __forceinline__ s16x4 vtr(lds_cptr p) { return __builtin_bit_cast(s16x4, __builtin_amdgcn_ds_read_tr16_b64_v4i16((LAS v4i16_t*)p)); }
__device__ __forceinline__ float xmax(float v) { auto rr = __builtin_amdgcn_permlane32_swap(__float_as_uint(v), __float_as_uint(v), false, false); return fmaxf(__uint_as_float(rr[0]), __uint_as_float(rr[1])); }
__device__ __forceinline__ float xsum(float v) { auto rr = __builtin_amdgcn_permlane32_swap(__float_as_uint(v), __float_as_uint(v), false, false); return __uint_as_float(rr[0]) + __uint_as_float(rr[1]); }

__device__ __forceinline__ void glds16(const void* gsrc, unsigned lds_dst) { unsigned keep;
    asm volatile("s_mov_b32 %0, m0\n\ts_mov_b32 m0, %2\n\ts_nop 0\n\tglobal_load_lds_dwordx4 %1, off\n\ts_mov_b32 m0, %0" : "=&s"(keep) : "v"(gsrc), "s"(lds_dst) : "memory"); }
__device__ __forceinline__ void glds16o(const void* sbase, unsigned voff, unsigned lds_dst) { unsigned keep;
    asm volatile("s_mov_b32 %0, m0\n\ts_mov_b32 m0, %3\n\ts_nop 0\n\tglobal_load_lds_dwordx4 %1, %2\n\ts_mov_b32 m0, %0" : "=&s"(keep) : "v"(voff), "s"(sbase), "s"(lds_dst) : "memory"); }
__device__ __forceinline__ float max3f(float a, float b, float c) { float r; asm("v_max3_f32 %0, %1, %2, %3" : "=v"(r) : "v"(a), "v"(b), "v"(c)); return r; }
template <bool SWA>
__device__ __forceinline__ void attn_unit(Frame& F, int b_first, int hh_first, int q0_first, float lam, int nblk) {
    constexpr int NDB = SWA ? 2 : 4;
    constexpr int KSL = SWA ? 8192 : 16384, VSL = SWA ? 8192 : 16384, NSL = 4, VRING = NSL * KSL, OPS = SWA ? 1 : 2;
    const int lane = F.lane, wid = F.wave, r32 = lane & 31, hi = lane >> 5;
    const int sub = wid >> 2, rw = wid & 3, grp = wid >> 2;
#define FA_COORD(i_, b_, hh_, q0_) do { if (SWA) { b_ = b_first; hh_ = hh_first; q0_ = q0_first + 64 * (i_); } else if (nblk == 1) { b_ = b_first; hh_ = hh_first; q0_ = q0_first; } \
        else { const int pr_ = (F.bid & 7) * 16 + 2 * (i_) + (F.bid >> 7), j_ = (F.bid >> 3) & 15; b_ = pr_ >> 2; hh_ = pr_ & 3; q0_ = 128 * (((i_) & 1) ? 15 - j_ : j_); } } while (0)
#define FA_QPTR(b_, hh_, q0_) (F.QKV + (size_t)(b_) * SEQ * NQKV + (size_t)((SWA ? (q0_) + 32 * (wid & 1) : (q0_) + 32 * rw) + r32) * NQKV + (SWA ? C_SQ + ((hh_) * 4 + (wid >> 1)) * 64 : C_DQ + (hh_) * 128 + sub * 64) + hi * 8)
    bf16x8 qn[4];
    if (SWA) { int b0_, h0_, q00_; FA_COORD(0, b0_, h0_, q00_); const bf16* qp_ = FA_QPTR(b0_, h0_, q00_);
#pragma unroll
      for (int s = 0; s < 4; ++s) qn[s] = *(const bf16x8*)(qp_ + s * 16); }
    const int krow = 8 * wid + (lane >> 3);
    LAS unsigned char* L = F.lds; const unsigned lds0 = (unsigned)(uintptr_t)L;
#define FA_GLDS(src, dstoff) glds16o(F.QKV, (src), (unsigned)__builtin_amdgcn_readfirstlane((int)(lds0 + (unsigned)(dstoff))))
#define FA_ISSUE_K(t, sl) do { const unsigned to_ = (unsigned)(t) * (64u * NQKV * 2u); const int sb_ = (sl) * KSL; \
        FA_GLDS(ksrc1 + to_, sb_ + wid * 1024); if (!SWA) FA_GLDS(ksrc1 + 128u + to_, sb_ + 8192 + wid * 1024); } while (0)
#define FA_ISSUE_V(t, sl) do { const unsigned to_ = (unsigned)(t) * (64u * NQKV * 2u); const int sb_ = VRING + (sl) * VSL; \
        FA_GLDS(vsrcA + to_, sb_ + wid * 1024); if (!SWA) FA_GLDS(vsrcA + 128u + to_, sb_ + (wid + 8) * 1024); } while (0)
    const int vq_ = (lane & 15) >> 2, vcl_ = 2 * ((lane >> 4) & 1) + ((lane & 3) >> 1);
    const lds_cptr vpl0 = (lds_cptr)(L + VRING) + (4 * hi + vq_) * 128 + (((4 * (vq_ >> 1)) + vcl_) * 16) + 8 * (lane & 1);
    const lds_cptr vpl1 = (lds_cptr)(L + VRING) + (4 * hi + vq_) * 128 + (((4 * (1 - (vq_ >> 1))) + vcl_) * 16) + 8 * (lane & 1);
    const lds_cptr kpl = (lds_cptr)L + (SWA ? 0 : sub * 8192) + r32 * 128;
    int koff[4];
#pragma unroll
    for (int s = 0; s < 4; ++s) koff[s] = ((2 * s + hi) ^ ((r32 >> 1) & 7)) << 4;
#pragma unroll 1
  for (int blk = 0; blk < nblk; ++blk) {
    int b, hh, q0; FA_COORD(blk, b, hh, q0);
    const int t0 = SWA ? (q0 >= 128 ? (q0 >> 6) - 2 : 0) : 0, t1 = SWA ? (q0 >> 6) + 1 : (q0 >> 6) + 2;
    const int qrow0 = SWA ? q0 + 32 * (wid & 1) : q0 + 32 * rw;
    const int hq = hh * 4 + (wid >> 1);
    const bool moreq = SWA && (blk + 1 < nblk), more = moreq;
    const bf16* rowbase = F.QKV + (size_t)b * SEQ * NQKV;
    const unsigned ksrc1 = (unsigned)(((size_t)b * SEQ + krow) * NQKV + (SWA ? C_SK + hh * 64 : C_DK + hh * 128) + (((lane & 7) ^ ((krow >> 1) & 7)) * 8)) * 2u;
    const unsigned vsrcA = (unsigned)(((size_t)b * SEQ + krow) * NQKV + (SWA ? C_SV + hh * 64 : C_DV + hh * 128) + (((lane & 7) ^ (((krow >> 1) & 1) << 2)) * 8)) * 2u;
    bf16x8 qr[4];
    if (SWA) {
#pragma unroll
        for (int s = 0; s < 4; ++s) qr[s] = qn[s]; }
    else { const bf16* qp_ = FA_QPTR(b, hh, q0);
#pragma unroll
        for (int s = 0; s < 4; ++s) qr[s] = *(const bf16x8*)(qp_ + s * 16); }
    if (moreq) { int nb_, nh_, nq_; FA_COORD(blk + 1, nb_, nh_, nq_); const bf16* qp_ = FA_QPTR(nb_, nh_, nq_);
#pragma unroll
        for (int s = 0; s < 4; ++s) qn[s] = *(const bf16x8*)(qp_ + s * 16); }
    f32x16 o[NDB];
#pragma unroll
    for (int d = 0; d < NDB; ++d) o[d] = f32x16{};
    f32x16 p0 = f32x16{}, p1 = f32x16{};
    v4u pw[4] = {};
    float m = 0.f, l = 0.f; bool unset = true;
    f32x16 negm = f32x16{};
    const int qg = qrow0 + r32;
    const int nt = t1 - t0;
    if (!SWA) { FA_ISSUE_K(t0, 0); if (1 < nt) FA_ISSUE_K(t0 + 1, 1); if (2 < nt) FA_ISSUE_K(t0 + 2, 2); FA_ISSUE_V(t0, 0); }
    else if (blk == 0) { for (int tt = t0; tt < t1; ++tt) { FA_ISSUE_K(tt, tt & 3); FA_ISSUE_V(tt, tt & 3); } }
#define FA_SB() __builtin_amdgcn_sched_barrier(0)
#define FA_SLOT(t_) (((SWA ? t0 : 0) + (t_)) & 3)
#define FA_VREAD(X, d_) do { const lds_cptr vq = (((d_) & 1) ? vp1 : vp0) + ((d_) >> 1) * 8192; _Pragma("unroll") for (int ks = 0; ks < 4; ++ks) { X##l[ks] = vtr(vq + ks * 2048); X##h[ks] = vtr(vq + ks * 2048 + 1024); } } while (0)
#define FA_VMMA(X, d_) do { _Pragma("unroll") for (int ks = 0; ks < 4; ++ks) { const bf16x8 va_ = (bf16x8){X##l[ks][0], X##l[ks][1], X##l[ks][2], X##l[ks][3], X##h[ks][0], X##h[ks][1], X##h[ks][2], X##h[ks][3]}; \
                o[d_] = __builtin_amdgcn_mfma_f32_32x32x16_bf16(va_, __builtin_bit_cast(bf16x8, pw[ks]), o[d_], 0, 0, 0); } } while (0)
#define FA_PV(t_) do { const lds_cptr vp0 = vpl0 + FA_SLOT(t_) * VSL, vp1 = vpl1 + FA_SLOT(t_) * VSL; s16x4 val[4], vah[4], vbl[4], vbh[4]; \
        FA_VREAD(va, 0); FA_SB(); FA_VREAD(vb, 1); FA_SB(); FA_VMMA(va, 0); FA_SB(); \
        if (NDB > 2) { FA_VREAD(va, 2); FA_SB(); } \
        FA_VMMA(vb, 1); FA_SB(); \
        if (NDB > 2) { FA_VREAD(vb, 3); FA_SB(); FA_VMMA(va, 2); FA_SB(); FA_VMMA(vb, 3); FA_SB(); } } while (0)
#define FA_QK(t_) do { const lds_cptr kp = kpl + FA_SLOT(t_) * KSL; bf16x8 ka[4], kb[4]; \
        _Pragma("unroll") for (int s = 0; s < 2; ++s) { ka[2 * s] = *(const LAS bf16x8*)(kp + koff[s]); ka[2 * s + 1] = *(const LAS bf16x8*)(kp + koff[s] + 4096); } \
        FA_SB(); \
        _Pragma("unroll") for (int s = 0; s < 2; ++s) { kb[2 * s] = *(const LAS bf16x8*)(kp + koff[s + 2]); kb[2 * s + 1] = *(const LAS bf16x8*)(kp + koff[s + 2] + 4096); } \
        FA_SB(); \
        p0 = __builtin_amdgcn_mfma_f32_32x32x16_bf16(ka[0], qr[0], negm, 0, 0, 0); p1 = __builtin_amdgcn_mfma_f32_32x32x16_bf16(ka[1], qr[0], negm, 0, 0, 0); \
        p0 = __builtin_amdgcn_mfma_f32_32x32x16_bf16(ka[2], qr[1], p0, 0, 0, 0); p1 = __builtin_amdgcn_mfma_f32_32x32x16_bf16(ka[3], qr[1], p1, 0, 0, 0); \
        FA_SB(); \
        p0 = __builtin_amdgcn_mfma_f32_32x32x16_bf16(kb[0], qr[2], p0, 0, 0, 0); p1 = __builtin_amdgcn_mfma_f32_32x32x16_bf16(kb[1], qr[2], p1, 0, 0, 0); \
        p0 = __builtin_amdgcn_mfma_f32_32x32x16_bf16(kb[2], qr[3], p0, 0, 0, 0); p1 = __builtin_amdgcn_mfma_f32_32x32x16_bf16(kb[3], qr[3], p1, 0, 0, 0); \
        FA_SB(); } while (0)
#define FA_SM(t_) do { const int tg = t0 + (t_); __builtin_amdgcn_s_setprio(2);   \
        if (SWA || (64 * tg + 63 > qrow0)) { \
            _Pragma("unroll") for (int r = 0; r < 16; ++r) { const int kv = 64 * tg + crow(r, hi); \
                const bool v0 = SWA ? (kv <= qg && qg - kv < 128) : (kv <= qg); \
                const bool v1 = SWA ? (kv + 32 <= qg && qg - kv - 32 < 128) : (kv + 32 <= qg); \
                p0[r] = v0 ? p0[r] : -1e30f; p1[r] = v1 ? p1[r] : -1e30f; } } \
        float mx = max3f(p0[0], p1[0], p0[1]); \
        mx = max3f(mx, p1[1], p0[2]); mx = max3f(mx, p1[2], p0[3]); mx = max3f(mx, p1[3], p0[4]); mx = max3f(mx, p1[4], p0[5]); mx = max3f(mx, p1[5], p0[6]); mx = max3f(mx, p1[6], p0[7]); \
        mx = max3f(mx, p1[7], p0[8]); mx = max3f(mx, p1[8], p0[9]); mx = max3f(mx, p1[9], p0[10]); mx = max3f(mx, p1[10], p0[11]); mx = max3f(mx, p1[11], p0[12]); mx = max3f(mx, p1[12], p0[13]); \
        mx = max3f(mx, p1[13], p0[14]); mx = max3f(mx, p1[14], p0[15]); mx = max3f(mx, p1[15], mx); \
        mx = xmax(mx); \
        { const bool rowvalid = mx > -1e29f; \
          if (__any(mx > FA_THR || (unset && rowvalid))) {                   \
            const float dl = rowvalid ? (unset ? mx : max3f(mx, 0.f, 0.f)) : 0.f, al = unset ? 1.f : __builtin_amdgcn_exp2f(-dl); \
            unset = unset && !rowvalid; m += dl; l *= al; \
            _Pragma("unroll") for (int d = 0; d < NDB; ++d) _Pragma("unroll") for (int r = 0; r < 16; ++r) o[d][r] *= al; \
            _Pragma("unroll") for (int r = 0; r < 16; ++r) { p0[r] -= dl; p1[r] -= dl; negm[r] = -m; } } } \
        float ls = 0.f; \
        _Pragma("unroll") for (int r = 0; r < 16; ++r) { const float e0 = __builtin_amdgcn_exp2f(p0[r]), e1 = __builtin_amdgcn_exp2f(p1[r]); p0[r] = e0; p1[r] = e1; ls += e0 + e1; } \
        l += ls; \
        _Pragma("unroll") for (int a = 0; a < 2; ++a) { \
            pw[a] = (v4u){cvtpk(p0[8 * a], p0[8 * a + 1]), cvtpk(p0[8 * a + 2], p0[8 * a + 3]), cvtpk(p0[8 * a + 4], p0[8 * a + 5]), cvtpk(p0[8 * a + 6], p0[8 * a + 7])}; \
            pw[2 + a] = (v4u){cvtpk(p1[8 * a], p1[8 * a + 1]), cvtpk(p1[8 * a + 2], p1[8 * a + 3]), cvtpk(p1[8 * a + 4], p1[8 * a + 5]), cvtpk(p1[8 * a + 6], p1[8 * a + 7])}; } \
        __builtin_amdgcn_s_setprio(0); } while (0)
#define FA_BAR() do { asm volatile("s_waitcnt lgkmcnt(0)" ::: "memory"); __builtin_amdgcn_s_barrier(); asm volatile("" ::: "memory"); } while (0)
#define FA_WAITV(n_) asm volatile("s_waitcnt vmcnt(%0)" :: "n"(n_) : "memory")
#define FA_EVEN(t_) do { FA_EVEN_WB(t_); FA_EVEN_ISSUE(t_); } while (0)
#define FA_ODD() do { } while (0)
#define FA_EVEN_WB(t_) do { if (SWA) { if ((t_) > 0) { if (more) FA_WAITV(2 * OPS); else FA_WAITV(0); } else if (blk == 0) FA_WAITV(0); else if (moreq) FA_WAITV(12); else FA_WAITV(8); }   \
        else { if ((t_) + 2 < nt) FA_WAITV(4 * OPS); else if ((t_) + 2 == nt) FA_WAITV(3 * OPS); else if ((t_) + 1 == nt) FA_WAITV(OPS); else FA_WAITV(0); } FA_BAR(); } while (0)
#define FA_EVEN_ISSUE(t_) do { if (SWA) { if ((t_) == 0 && more) { FA_ISSUE_K(t1, t1 & 3); FA_ISSUE_V(t1, t1 & 3); } } \
        else { if ((t_) + 3 < nt) FA_ISSUE_K(t0 + (t_) + 3, ((t_) + 3) & 3); if ((t_) + 2 < nt) FA_ISSUE_V(t0 + (t_) + 2, ((t_) + 2) & 3); } } while (0)
#define FA_KREAD(X, s0_) do { _Pragma("unroll") for (int s = 0; s < 2; ++s) { X[2 * s] = *(const LAS bf16x8*)(kp + koff[s + (s0_)]); X[2 * s + 1] = *(const LAS bf16x8*)(kp + koff[s + (s0_)] + 4096); } } while (0)
#define FA_QKA() do { p0 = __builtin_amdgcn_mfma_f32_32x32x16_bf16(ka[0], qr[0], negm, 0, 0, 0); p1 = __builtin_amdgcn_mfma_f32_32x32x16_bf16(ka[1], qr[0], negm, 0, 0, 0); \
        p0 = __builtin_amdgcn_mfma_f32_32x32x16_bf16(ka[2], qr[1], p0, 0, 0, 0); p1 = __builtin_amdgcn_mfma_f32_32x32x16_bf16(ka[3], qr[1], p1, 0, 0, 0); } while (0)
#define FA_QKB() do { p0 = __builtin_amdgcn_mfma_f32_32x32x16_bf16(kb[0], qr[2], p0, 0, 0, 0); p1 = __builtin_amdgcn_mfma_f32_32x32x16_bf16(kb[1], qr[2], p1, 0, 0, 0); \
        p0 = __builtin_amdgcn_mfma_f32_32x32x16_bf16(kb[2], qr[3], p0, 0, 0, 0); p1 = __builtin_amdgcn_mfma_f32_32x32x16_bf16(kb[3], qr[3], p1, 0, 0, 0); } while (0)
#define FA_PVQK(tpv_, tqk_, ISSUE_) do { const lds_cptr vp0 = vpl0 + FA_SLOT(tpv_) * VSL, vp1 = vpl1 + FA_SLOT(tpv_) * VSL; const lds_cptr kp = kpl + FA_SLOT(tqk_) * KSL; s16x4 val[4], vah[4], vbl[4], vbh[4]; bf16x8 ka[4], kb[4]; \
        FA_VREAD(va, 0); FA_SB(); FA_VREAD(vb, 1); FA_SB(); ISSUE_; FA_SB(); \
        if (NDB > 2) { FA_VMMA(va, 0); FA_SB(); FA_VREAD(va, 2); FA_SB(); FA_VMMA(vb, 1); FA_SB(); FA_VREAD(vb, 3); FA_SB(); FA_VMMA(va, 2); FA_SB(); FA_KREAD(ka, 0); FA_SB(); FA_VMMA(vb, 3); FA_SB(); FA_KREAD(kb, 2); FA_SB(); } \
        else { FA_KREAD(ka, 0); FA_SB(); FA_VMMA(va, 0); FA_SB(); FA_KREAD(kb, 2); FA_SB(); FA_VMMA(vb, 1); FA_SB(); } \
        FA_QKA(); FA_SB(); FA_QKB(); FA_SB(); } while (0)
    if constexpr (!SWA) {
#define FA_MASKMAX(i_) const int tg = t0 + (i_); \
        if (64 * tg + 63 > qrow0) { \
            _Pragma("unroll") for (int r = 0; r < 16; ++r) { const int kv = 64 * tg + crow(r, hi); p0[r] = (kv <= qg) ? p0[r] : -1e30f; p1[r] = (kv + 32 <= qg) ? p1[r] : -1e30f; } } \
        float mx = max3f(p0[0], p1[0], p0[1]); \
        mx = max3f(mx, p1[1], p0[2]); mx = max3f(mx, p1[2], p0[3]); mx = max3f(mx, p1[3], p0[4]); mx = max3f(mx, p1[4], p0[5]); mx = max3f(mx, p1[5], p0[6]); mx = max3f(mx, p1[6], p0[7]); \
        mx = max3f(mx, p1[7], p0[8]); mx = max3f(mx, p1[8], p0[9]); mx = max3f(mx, p1[9], p0[10]); mx = max3f(mx, p1[10], p0[11]); mx = max3f(mx, p1[11], p0[12]); mx = max3f(mx, p1[12], p0[13]); \
        mx = max3f(mx, p1[13], p0[14]); mx = max3f(mx, p1[14], p0[15]); mx = max3f(mx, p1[15], mx); \
        mx = xmax(mx); const bool rowvalid = mx > -1e29f;
#define FA_RESCALE() do { const float dl = rowvalid ? (unset ? mx : max3f(mx, 0.f, 0.f)) : 0.f; al_ = unset ? 1.f : __builtin_amdgcn_exp2f(-dl); \
            unset = unset && !rowvalid; m += dl; l *= al_; \
            _Pragma("unroll") for (int d = 0; d < NDB; ++d) _Pragma("unroll") for (int r = 0; r < 16; ++r) o[d][r] *= al_; \
            _Pragma("unroll") for (int r = 0; r < 16; ++r) { p0[r] -= dl; p1[r] -= dl; negm[r] = -m; } } while (0)
#define FA_EXPPACK() do { float ls = 0.f; \
        _Pragma("unroll") for (int r = 0; r < 16; ++r) { const float e0 = __builtin_amdgcn_exp2f(p0[r]), e1 = __builtin_amdgcn_exp2f(p1[r]); p0[r] = e0; p1[r] = e1; ls += e0 + e1; } \
        l += ls; \
        _Pragma("unroll") for (int a = 0; a < 2; ++a) { \
            pw[a] = (v4u){cvtpk(p0[8 * a], p0[8 * a + 1]), cvtpk(p0[8 * a + 2], p0[8 * a + 3]), cvtpk(p0[8 * a + 4], p0[8 * a + 5]), cvtpk(p0[8 * a + 6], p0[8 * a + 7])}; \
            pw[2 + a] = (v4u){cvtpk(p1[8 * a], p1[8 * a + 1]), cvtpk(p1[8 * a + 2], p1[8 * a + 3]), cvtpk(p1[8 * a + 4], p1[8 * a + 5]), cvtpk(p1[8 * a + 6], p1[8 * a + 7])}; } } while (0)
#define FA_VF(X, d_, ks_) do { const lds_cptr vq_ = (((d_) & 1) ? vp1 : vp0) + ((d_) >> 1) * 8192; X##l[d_] = vtr(vq_ + (ks_) * 2048); X##h[d_] = vtr(vq_ + (ks_) * 2048 + 1024); } while (0)
#define FA_PVM(X, d_, ks_) do { const bf16x8 va_ = (bf16x8){X##l[d_][0], X##l[d_][1], X##l[d_][2], X##l[d_][3], X##h[d_][0], X##h[d_][1], X##h[d_][2], X##h[d_][3]}; \
        o[d_] = __builtin_amdgcn_mfma_f32_32x32x16_bf16(va_, __builtin_bit_cast(bf16x8, pw[ks_]), o[d_], 0, 0, 0); } while (0)
#define FA_E0(r_) p0[r_] = __builtin_amdgcn_exp2f(p0[r_])
#define FA_E1(r_) p1[r_] = __builtin_amdgcn_exp2f(p1[r_])
#define FA_KF(X, j_) X[j_] = *(const LAS bf16x8*)(kp + koff[(j_) >> 1] + ((j_) & 1) * 4096)
#define FA_KG(X, j_) X[j_] = *(const LAS bf16x8*)(kp + koff[2 + ((j_) >> 1)] + ((j_) & 1) * 4096)
#define FA_FAST(tpv_, tqk_, DOQK_) do { const lds_cptr vp0 = vpl0 + FA_SLOT(tpv_) * VSL, vp1 = vpl1 + FA_SLOT(tpv_) * VSL; const lds_cptr kp = kpl + FA_SLOT(tqk_) * KSL; \
        s16x4 fal[4], fah[4], fbl[4], fbh[4]; bf16x8 ka[4], kb[4]; float ls = 0.f; \
        FA_VF(fa, 0, 0); FA_VF(fa, 1, 0); FA_VF(fa, 2, 0); FA_VF(fa, 3, 0); FA_VF(fb, 0, 1); FA_VF(fb, 1, 1); FA_VF(fb, 2, 1); FA_VF(fb, 3, 1); FA_SB(); \
        FA_PVM(fa, 0, 0); FA_E0(0); FA_E0(1); FA_SB(); \
        FA_PVM(fa, 1, 0); FA_E0(2); FA_E0(3); ls += p0[0] + p0[1]; FA_SB(); \
        FA_PVM(fa, 2, 0); FA_E0(4); FA_E0(5); ls += p0[2] + p0[3]; FA_SB(); \
        FA_PVM(fa, 3, 0); FA_E0(6); FA_E0(7); ls += p0[4] + p0[5]; FA_SB(); \
        FA_PVM(fb, 0, 1); FA_E0(8); FA_E0(9); ls += p0[6] + p0[7]; pw[0][0] = cvtpk(p0[0], p0[1]); FA_VF(fa, 0, 2); FA_SB(); \
        FA_PVM(fb, 1, 1); FA_E0(10); FA_E0(11); ls += p0[8] + p0[9]; pw[0][1] = cvtpk(p0[2], p0[3]); FA_VF(fa, 1, 2); FA_SB(); \
        FA_PVM(fb, 2, 1); FA_E0(12); FA_E0(13); ls += p0[10] + p0[11]; pw[0][2] = cvtpk(p0[4], p0[5]); FA_VF(fa, 2, 2); FA_SB(); \
        FA_PVM(fb, 3, 1); FA_E0(14); FA_E0(15); ls += p0[12] + p0[13]; pw[0][3] = cvtpk(p0[6], p0[7]); FA_VF(fa, 3, 2); FA_SB(); \
        FA_PVM(fa, 0, 2); FA_E1(0); FA_E1(1); ls += p0[14] + p0[15]; pw[1][0] = cvtpk(p0[8], p0[9]); FA_VF(fb, 0, 3); FA_SB(); \
        FA_PVM(fa, 1, 2); FA_E1(2); FA_E1(3); ls += p1[0] + p1[1]; pw[1][1] = cvtpk(p0[10], p0[11]); FA_VF(fb, 1, 3); FA_SB(); \
        FA_PVM(fa, 2, 2); FA_E1(4); FA_E1(5); ls += p1[2] + p1[3]; pw[1][2] = cvtpk(p0[12], p0[13]); FA_VF(fb, 2, 3); FA_SB(); \
        FA_PVM(fa, 3, 2); FA_E1(6); FA_E1(7); ls += p1[4] + p1[5]; pw[1][3] = cvtpk(p0[14], p0[15]); FA_VF(fb, 3, 3); FA_SB(); \
        FA_PVM(fb, 0, 3); FA_E1(8); FA_E1(9); ls += p1[6] + p1[7]; pw[2][0] = cvtpk(p1[0], p1[1]); if (DOQK_) FA_KF(ka, 0); FA_SB(); \
        FA_PVM(fb, 1, 3); FA_E1(10); FA_E1(11); ls += p1[8] + p1[9]; pw[2][1] = cvtpk(p1[2], p1[3]); if (DOQK_) FA_KF(ka, 1); FA_SB(); \
        FA_PVM(fb, 2, 3); FA_E1(12); FA_E1(13); ls += p1[10] + p1[11]; pw[2][2] = cvtpk(p1[4], p1[5]); if (DOQK_) FA_KF(ka, 2); FA_SB(); \
        FA_PVM(fb, 3, 3); FA_E1(14); FA_E1(15); ls += p1[12] + p1[13]; pw[2][3] = cvtpk(p1[6], p1[7]); if (DOQK_) FA_KF(ka, 3); FA_SB(); \
        ls += p1[14] + p1[15]; l += ls; pw[3] = (v4u){cvtpk(p1[8], p1[9]), cvtpk(p1[10], p1[11]), cvtpk(p1[12], p1[13]), cvtpk(p1[14], p1[15])}; FA_SB(); \
        if (DOQK_) { \
            p0 = __builtin_amdgcn_mfma_f32_32x32x16_bf16(ka[0], qr[0], negm, 0, 0, 0); FA_KG(kb, 0); FA_SB(); \
            p1 = __builtin_amdgcn_mfma_f32_32x32x16_bf16(ka[1], qr[0], negm, 0, 0, 0); FA_KG(kb, 1); FA_SB(); \
            p0 = __builtin_amdgcn_mfma_f32_32x32x16_bf16(ka[2], qr[1], p0, 0, 0, 0); FA_KG(kb, 2); FA_SB(); \
            p1 = __builtin_amdgcn_mfma_f32_32x32x16_bf16(ka[3], qr[1], p1, 0, 0, 0); FA_KG(kb, 3); FA_SB(); \
            p0 = __builtin_amdgcn_mfma_f32_32x32x16_bf16(kb[0], qr[2], p0, 0, 0, 0); p1 = __builtin_amdgcn_mfma_f32_32x32x16_bf16(kb[1], qr[2], p1, 0, 0, 0); \
            p0 = __builtin_amdgcn_mfma_f32_32x32x16_bf16(kb[2], qr[3], p0, 0, 0, 0); p1 = __builtin_amdgcn_mfma_f32_32x32x16_bf16(kb[3], qr[3], p1, 0, 0, 0); FA_SB(); } } while (0)
        if (2 < nt) FA_WAITV(3 * OPS); else FA_WAITV(2 * OPS);
        FA_BAR(); FA_QK(0);
#define FA_RESCALE_ALL() do { FA_RESCALE(); \
            _Pragma("unroll") for (int k = 0; k < 4; ++k) _Pragma("unroll") for (int j = 0; j < 4; ++j) { const unsigned w_ = pw[k][j]; pw[k][j] = cvtpk(bflo(w_) * al_, bfhi(w_) * al_); } } while (0)
#define FA_BLOCK_TOP(i_) \
            if ((i_) + 2 < nt) FA_WAITV(2 * OPS); else FA_WAITV(OPS);       \
            FA_BAR(); \
            if ((i_) + 3 < nt) FA_ISSUE_K(t0 + (i_) + 3, ((i_) + 3) & 3); \
            if ((i_) + 1 < nt) FA_ISSUE_V(t0 + (i_) + 1, ((i_) + 1) & 3); \
            FA_MASKMAX(i_)
        { FA_BLOCK_TOP(0) float al_; FA_RESCALE(); (void)al_; FA_EXPPACK(); FA_QK(1); }
#pragma unroll 1
        for (int i = 1; i < nt - 1; ++i) { FA_BLOCK_TOP(i) if (__any(mx > FA_THR)) { float al_; FA_RESCALE_ALL(); } FA_FAST(i - 1, i + 1, true); }
        { const int i = nt - 1; FA_BLOCK_TOP(i) if (__any(mx > FA_THR)) { float al_; FA_RESCALE_ALL(); } FA_FAST(i - 1, i - 1, false); }
        FA_WAITV(0); FA_BAR(); FA_PV(nt - 1);
#undef FA_RESCALE_ALL
#undef FA_BLOCK_TOP
#undef FA_MASKMAX
#undef FA_RESCALE
#undef FA_EXPPACK
#undef FA_VF
#undef FA_PVM
#undef FA_E0
#undef FA_E1
#undef FA_KF
#undef FA_KG
#undef FA_FAST
    } else {
    if (grp == 0) {
        FA_EVEN(0); FA_QK(0);
#pragma unroll 1
        for (int t = 0; t < nt - 1; ++t) { FA_ODD(); FA_SM(t); FA_EVEN_WB(t + 1); FA_PVQK(t, t + 1, FA_EVEN_ISSUE(t + 1)); }
        FA_ODD(); FA_SM(nt - 1); FA_EVEN(nt); FA_PV(nt - 1); FA_ODD();
    } else {
        FA_EVEN(0); FA_ODD(); FA_QK(0);
#pragma unroll 1
        for (int t = 0; t < nt - 1; ++t) { FA_EVEN(t + 1); FA_SM(t); FA_ODD(); FA_PVQK(t, t + 1, (void)0); }
        FA_EVEN(nt); FA_SM(nt - 1); FA_ODD(); FA_PV(nt - 1);
    }
    }
#undef FA_SB
#undef FA_SLOT
#undef FA_VREAD
#undef FA_VMMA
#undef FA_PV
#undef FA_QK
#undef FA_SM
#undef FA_EVEN
#undef FA_EVEN_WB
#undef FA_EVEN_ISSUE
#undef FA_KREAD
#undef FA_QKA
#undef FA_QKB
#undef FA_PVQK
#undef FA_WAITV
#undef FA_BAR
#undef FA_ODD
#undef FA_ISSUE_K
#undef FA_ISSUE_V
#undef FA_GLDS
#define FA_BAR2() do { asm volatile("s_waitcnt lgkmcnt(0)" ::: "memory"); __builtin_amdgcn_s_barrier(); asm volatile("" ::: "memory"); } while (0)
    if (moreq) { asm volatile("" : "+v"(qn[0]), "+v"(qn[1]), "+v"(qn[2]), "+v"(qn[3])); }
    float lt = xsum(l);
    if (SWA) lt += __builtin_amdgcn_exp2f(F.swa_sinks[hq] * LOG2E - m);
    const float inv = 1.f / lt;
    const size_t tok = (size_t)b * SEQ + qg;
    if (SWA) {
        bf16* op = F.ACT + tok * D + 512 + hq * 64;
#pragma unroll
        for (int d = 0; d < NDB; ++d)
#pragma unroll
            for (int g4 = 0; g4 < 4; ++g4) { const int dd = 32 * d + 8 * g4 + 4 * hi;
                v2u w; w.x = cvtpk(o[d][4 * g4] * inv, o[d][4 * g4 + 1] * inv); w.y = cvtpk(o[d][4 * g4 + 2] * inv, o[d][4 * g4 + 3] * inv);
                *(v2u*)(op + dd) = w; }
        if (!more) FA_BAR2();
    } else {
        LAS float* comb = (LAS float*)L;
        if (sub == 1) {
#pragma unroll
            for (int d = 0; d < NDB; ++d)
#pragma unroll
                for (int r = 0; r < 16; ++r) comb[(rw * 64 + d * 16 + r) * 64 + lane] = o[d][r] * inv;
        }
        FA_BAR2();
        if (sub == 0) {
            const LAS float* gd = (const LAS float*)(L + RING_BYTES + 1024);
            float ss = 0.f;
#pragma unroll
            for (int d = 0; d < NDB; ++d)
#pragma unroll
                for (int r = 0; r < 16; ++r) { const float v = o[d][r] * inv - lam * comb[(rw * 64 + d * 16 + r) * 64 + lane]; o[d][r] = v; ss += v * v; }
            ss = xsum(ss);
            const float rn = 0.8f / sqrtf(ss * (1.f / 128.f) + EPS);
            bf16* op = F.ACT + tok * D + hh * 128;
#pragma unroll
            for (int d = 0; d < NDB; ++d)
#pragma unroll
                for (int g4 = 0; g4 < 4; ++g4) { const int dd = 32 * d + 8 * g4 + 4 * hi; const f32x4 g = *(const LAS f32x4*)(gd + dd);
                    v2u w; w.x = cvtpk(o[d][4 * g4] * rn * g.x, o[d][4 * g4 + 1] * rn * g.y); w.y = cvtpk(o[d][4 * g4 + 2] * rn * g.z, o[d][4 * g4 + 3] * rn * g.w);
                    *(v2u*)(op + dd) = w; }
        }
        FA_BAR2();
    }
  }
#undef FA_COORD
#undef FA_QPTR
}
#undef FA_BAR2
}

__device__ __forceinline__ void ph_attn(Frame& F) {
    const float lam = diff_lambda_value(F);
    if (F.tid < 128) ((LAS float*)(F.lds + RING_BYTES + 1024))[F.tid] = F.g_diff_sub[F.tid];
    __syncthreads();
    if (F.G == 256) fa::attn_unit<false>(F, 0, 0, 0, lam, 8);
    else {
#pragma unroll 1
        for (int u = F.bid; u < BATCH * 4 * 16; u += F.G) { const int pair = u >> 4, qb = u & 15; fa::attn_unit<false>(F, pair >> 2, pair & 3, qb * 128, lam, 1); }
    }
    for (int u = F.bid * 8; u < BATCH * 2 * 32; u += F.G * 8) {
        const int qb = u & 31, kvh = (u >> 5) & 1, b = u >> 6;
        fa::attn_unit<true>(F, b, kvh, qb * 64, 0.f, 8);
    }
}

struct Args { const float* in[19]; float* out; unsigned char* ws; int ph_lo, ph_hi; };
__global__ void __launch_bounds__(NWAVES * 64, 2) mk_fwd(Args args) {
    extern __shared__ __attribute__((aligned(16))) unsigned char lds[];
    Frame F;
    F.lds = (LAS unsigned char*)lds;
    F.wave = __builtin_amdgcn_readfirstlane((int)threadIdx.x >> 6); F.lane = fresh_lane(); F.tid = F.wave * 64 + F.lane;
#define REFRESH_IDS() do { F.lane = fresh_lane(); F.tid = F.wave * 64 + F.lane; } while (0)
    F.G = gridDim.x; F.bid = blockIdx.x;
    unsigned char* ws = args.ws; F.ws = ws; F.ctl = (unsigned*)(ws + WS_CTL);
    F.x = args.in[0]; F.c = args.in[1]; F.w_ada = args.in[2]; F.b_ada = args.in[3]; F.g_mix = args.in[4]; F.w_in = args.in[5]; F.diff_lambda = args.in[6]; F.g_diff_sub = args.in[7];
    F.swa_sinks = args.in[8]; F.w_out = args.in[9]; F.g_ffn = args.in[10]; F.w_rg = args.in[11]; F.b_rg = args.in[12]; F.w_re = args.in[13]; F.b_re = args.in[14];
    F.w_gate = args.in[15]; F.w_up = args.in[16]; F.w_down = args.in[17]; F.g_final = args.in[18]; F.out = args.out;
    F.mod = (float*)(ws + WS_MOD); F.rope = (float*)(ws + WS_ROPE);
    F.tok_e = (int*)(ws + WS_TOK); F.tok_r0 = F.tok_e + T; F.tok_r1 = F.tok_e + 2 * T; F.tok_w0 = (float*)(F.tok_e + 3 * T); F.tok_w1 = (float*)(F.tok_e + 4 * T);
    F.list = (int*)(ws + WS_LIST);
    F.WinT = (bf16*)(ws + WS_WIN); F.WoT = (bf16*)(ws + WS_WO); F.WguT = ws + WS_WGU; F.WdT = ws + WS_WD;
    F.ACT = (bf16*)(ws + WS_ACT); F.QKV = (bf16*)(ws + WS_QKV); F.Y = ws + WS_QKV;
    F.X1 = (bf16*)(ws + WS_GU); F.ACTM = ws + WS_ACTM; F.H8 = ws + WS_ACT;
    for (int u = F.tid; u < (LDS_BYTES - RING_BYTES) / 4; u += NWAVES * 64) ((LAS unsigned*)(F.lds + RING_BYTES))[u] = 0u;
    __syncthreads();
    XcdBarrier bar; bar.bar = (unsigned*)(F.ctl + CW_BAR); bar.x = 0; bar.st = nullptr;
#if MK_ONE_LAUNCH
    bar = xcd_barrier_post((unsigned*)(F.ctl + CW_BAR), (volatile LAS unsigned*)(F.lds + MISC_OFF));
#endif
    const int lo = args.ph_lo, hi = args.ph_hi;
#define IN(k) (lo <= (k) && (k) < hi)
#if MK_ONE_LAUNCH
#define SEAM(k) do { if (IN(k) && IN((k) + 1)) xcd_barrier(bar); } while (0)
#else
#define SEAM(k) do { } while (0)
#endif
    if (IN(0)) { REFRESH_IDS(); ph_prologue(F); SEAM(0); }
    if (IN(1)) { REFRESH_IDS(); ph_norm1(F); SEAM(1); }
    if (IN(2)) {
        REFRESH_IDS();
        const int kall = (12288 + F.G * NWAVES - 1) / (F.G * NWAVES), kpre = (((F.bid >> 3) % 3) * kall) / 2 < kall ? (((F.bid >> 3) % 3) * kall) / 2 : kall;
        expert_items(F, 0, kpre);
        __syncthreads();
        {
            pg8::Gemm g{F.ACT, F.WinT, T, NQKV, D, 0}; pg8::StaticOrder S; S.init(T, NQKV, F.G, F.bid);
            pg8::EpiRope E{F.QKV, NQKV, F.rope};
            pg8::gemm_phase<pg8::EpiRope, pg8::StaticOrder, true, true>(F.lds, g, S, E, F.wave);
        }
        REFRESH_IDS();
        expert_items(F, kpre, kall);
        SEAM(2);
    }
    if (IN(3)) { REFRESH_IDS(); ph_attn(F); SEAM(3); }
    if (IN(4)) {
        pg8::Gemm g{F.ACT, F.WoT, T, D, D, 0}; pg8::StaticOrder S; S.init(T, D, F.G, F.bid);
        pg8::EpiResid E{F.x, F.X1, F.mod};
        pg8::gemm_phase<pg8::EpiResid, pg8::StaticOrder, true, true>(F.lds, g, S, E, F.wave);
        SEAM(4);
    }
    if (IN(5)) { REFRESH_IDS(); ph_norm2_route(F); SEAM(5); }
    if (IN(6)) { REFRESH_IDS();
        LAS int* ts = (LAS int*)(F.lds + RING_BYTES); load_tstart(F, ts);
        pg8::Gemm g{(const bf16*)F.H8, (const bf16*)F.WguT, T, 1024, D / 2, (size_t)1024 * 1024}; pg8::MoeOrder S{4, F.G, F.bid, __builtin_amdgcn_readfirstlane(ts[16]), (const PG8_LAS int*)ts};
        LAS unsigned* gath = (LAS unsigned*)(F.lds + RING_BYTES + 2048);
        for (int i = 0; i < 9; ++i) { pg8::Unit u; if (!S.next(i, u)) break;
            if (F.tid < 256) { const int rk = (u.pm - ts[u.e]) * 256 + F.tid, n = ts[32 + u.e];
                const unsigned tok = __hip_atomic_load((unsigned*)F.list + (size_t)u.e * T + (rk < n ? rk : 0), RLX_AGENT); gath[i * 256 + F.tid] = tok * 1024u; } }
        __syncthreads();
        pg8::EpiSwiGLU E{F.ACTM};
        pg8::gemm_phase<pg8::EpiSwiGLU, pg8::MoeOrder, true, true, true, true>(F.lds, g, S, E, F.wave, (const PG8_LAS unsigned*)gath);
        SEAM(6);
    }
    if (IN(7)) { REFRESH_IDS();
        LAS int* ts = (LAS int*)(F.lds + RING_BYTES); load_tstart(F, ts);
        pg8::Gemm g{(const bf16*)F.ACTM, (const bf16*)F.WdT, SORT_ROWS, 1024, DEXP / 2, (size_t)1024 * 512}; pg8::MoeOrder S{4, F.G, F.bid, __builtin_amdgcn_readfirstlane(ts[16]), (const PG8_LAS int*)ts};
        pg8::EpiPlain8 E{F.Y, 1024};
        pg8::gemm_phase<pg8::EpiPlain8, pg8::MoeOrder, true, true, false, true>(F.lds, g, S, E, F.wave);
        SEAM(7);
    }
    if (IN(8)) { REFRESH_IDS(); ph_final(F); }
#undef IN
#undef SEAM
}

extern "C" void kernel_launch(void* const* d_in, const int* in_sizes, int n_in, void* d_out, int out_size, void* d_ws, size_t ws_size, hipStream_t stream) {
    static int grid = 0;
    if (grid == 0) {
        if (n_in != 19 || in_sizes[0] != T * D || out_size != T * D || ws_size < WS_END) { fprintf(stderr, "kernel_launch: unexpected shapes/workspace: n_in %d in0 %d out %d ws %zu (need %zu); nothing launched\n", n_in, n_in > 0 ? in_sizes[0] : -1, out_size, ws_size, (size_t)WS_END); grid = -1; return; }
        int dev = 0, cus = 0, per_cu = 0;
        if (hipGetDevice(&dev) != hipSuccess || hipDeviceGetAttribute(&cus, hipDeviceAttributeMultiprocessorCount, dev) != hipSuccess) { fprintf(stderr, "kernel_launch: device query failed\n"); grid = -1; return; }
        if (hipFuncSetAttribute((const void*)mk_fwd, hipFuncAttributeMaxDynamicSharedMemorySize, LDS_BYTES) != hipSuccess) { fprintf(stderr, "kernel_launch: hipFuncSetAttribute failed\n"); grid = -1; return; }
        if (hipOccupancyMaxActiveBlocksPerMultiprocessor(&per_cu, (const void*)mk_fwd, NWAVES * 64, LDS_BYTES) != hipSuccess || per_cu < 1)
            fprintf(stderr, "kernel_launch: note: occupancy query reports %d workgroups per CU\n", per_cu);
        (void)hipGetLastError();
        grid = cus;
    }
    if (grid < 0) return;
    if (hipMemsetAsync((char*)d_ws + WS_CTL, 0, CTL_ZERO_BYTES, stream) != hipSuccess) { fprintf(stderr, "kernel_launch: memset failed\n"); return; }
    Args a{};
    for (int i = 0; i < 19; ++i) a.in[i] = (const float*)d_in[i];
    a.out = (float*)d_out; a.ws = (unsigned char*)d_ws;
#if MK_ONE_LAUNCH
    a.ph_lo = 0; a.ph_hi = N_PHASES;
    hipLaunchKernelGGL(mk_fwd, dim3(grid), dim3(NWAVES * 64), LDS_BYTES, stream, a);
#else
    for (int p = 0; p < N_PHASES; ++p) { a.ph_lo = p; a.ph_hi = p + 1; hipLaunchKernelGGL(mk_fwd, dim3(grid), dim3(NWAVES * 64), LDS_BYTES, stream, a); }
#endif
    const hipError_t le = hipPeekAtLastError();
    if (le != hipSuccess) fprintf(stderr, "kernel_launch: launch failed: %s\n", hipGetErrorName(le));
}
```

```cpp
#include <hip/hip_runtime.h>
#include <cstdio>
#include <cstdint>
namespace pg8 {
#define PG8_LAS __attribute__((address_space(3)))
typedef unsigned short bf16_t;
typedef short bf16x8 __attribute__((ext_vector_type(8)));
typedef float f32x4 __attribute__((ext_vector_type(4)));
typedef unsigned u32x4 __attribute__((ext_vector_type(4)));
constexpr int BM = 256, BK = 64, HALF = 128, HTB = HALF * BK * 2  , STAGE_BYTES = 8 * HTB, NXCD = 8, WGM = 8;

__host__ __device__ __forceinline__ int lds_byte(int r, int c) { const int st = (r >> 4) * 2 + (c >> 5), rr = r & 15, cc = c & 31, ob = rr * 64 + cc * 2; return st * 1024 + (ob ^ (((ob >> 9) & 1) << 5)); }
__host__ __device__ __forceinline__ void stage_rc(int b, int& R, int& C) { const int st = b / 1024, sb = b % 1024, swz = sb ^ (((sb >> 9) & 1) << 5); R = (st >> 1) * 16 + swz / 64; C = (st & 1) * 32 + (swz % 64) / 2; }
__host__ __device__ __forceinline__ int perm32(int rho) { const int n = rho >> 4, i = rho & 15; return 8 * (i >> 2) + 4 * n + (i & 3); }

struct Unit { int pm, pn, e; };
struct Gemm { const bf16_t* A; const bf16_t* Bt; int M, N, K; size_t bstride; };

struct StaticOrder {
    int nM, nN, nwg, G, c;
    __host__ __device__ void init(int M, int N, int G_, int c_) { nM = M / BM; nN = N / BM; nwg = nM * nN; G = G_; c = c_; }
    __host__ __device__ bool next(int i, Unit& u) const {
        const long L = (long)i * G + c; if (L >= nwg) return false;
        int wgid = (int)L; { const int q = nwg / NXCD, r = nwg % NXCD, xcd = wgid % NXCD, off = wgid / NXCD; wgid = (xcd < r ? xcd * (q + 1) : r * (q + 1) + (xcd - r) * q) + off; }
        const int nig = WGM * nN, gid = wgid / nig, fm = gid * WGM, gsz = (nM - fm) < WGM ? (nM - fm) : WGM;
        u.pm = fm + ((wgid % nig) % gsz); u.pn = (wgid % nig) / gsz; u.e = 0; return true;
    }
    __device__ __forceinline__ void a_ready(const Unit&) const {}
    __device__ __forceinline__ void done(const Unit&) const {}
};

__device__ __forceinline__ unsigned cvt_pk_bf16(float lo, float hi) { unsigned r; asm volatile("v_cvt_pk_bf16_f32 %0, %1, %2" : "=v"(r) : "v"(lo), "v"(hi)); return r; }
typedef float f32x2 __attribute__((ext_vector_type(2)));
typedef unsigned u32x2 __attribute__((ext_vector_type(2)));
typedef int v4i_t __attribute__((ext_vector_type(4)));
typedef int v8i_t __attribute__((ext_vector_type(8)));

struct EpiPlain {
    static constexpr bool PERM = true, AFTER_DRAIN = false, WIDE = false; static constexpr int NST = 16;
    bf16_t* O; int ldc;
    __device__ __forceinline__ void operator()(const f32x4 (&acc)[2][2][4][2], const Unit& u, int wr, int wc, int fr, int fq) const {
        const int row0 = u.pm * BM + wr * 64 + fr; const int col0 = u.pn * BM + wc * 32 + 8 * fq;
#pragma unroll
        for (int ai = 0; ai < 2; ++ai)
#pragma unroll
            for (int m = 0; m < 4; ++m) { bf16_t* rowp = O + (size_t)(row0 + ai * HALF + m * 16) * ldc + col0;
#pragma unroll
                for (int bj = 0; bj < 2; ++bj) { const f32x4 v0 = acc[ai][bj][m][0], v1 = acc[ai][bj][m][1];
                    u32x4 w; w.x = cvt_pk_bf16(v0[0], v0[1]); w.y = cvt_pk_bf16(v0[2], v0[3]); w.z = cvt_pk_bf16(v1[0], v1[1]); w.w = cvt_pk_bf16(v1[2], v1[3]);
                    *(u32x4*)(rowp + bj * HALF) = w; } }
    }
};
struct EpiPlain8 {
    static constexpr bool PERM = true, AFTER_DRAIN = false, WIDE = true; static constexpr int NST = 8;
    unsigned char* O; int ldc;
    __device__ __forceinline__ void operator()(const f32x4 (&acc)[2][2][4][2], const Unit& u, int wr, int wc, int fr, int fq) const {
        const int row0 = u.pm * BM + wr * 64 + fr; const int col0 = u.pn * BM + wc * 64 + 16 * fq;
#pragma unroll
        for (int ai = 0; ai < 2; ++ai)
#pragma unroll
            for (int m = 0; m < 4; ++m) { unsigned char* rowp = O + (size_t)(row0 + ai * HALF + m * 16) * ldc + col0; int w[4];
#pragma unroll
                for (int bj = 0; bj < 2; ++bj) { f32x4 v0 = acc[ai][bj][m][0], v1 = acc[ai][bj][m][1];
#pragma unroll
                    for (int j = 0; j < 4; ++j) { v0[j] = __builtin_fminf(__builtin_fmaxf(v0[j], -448.f), 448.f); v1[j] = __builtin_fminf(__builtin_fmaxf(v1[j], -448.f), 448.f); }
                    int w0 = 0, w1 = 0; w0 = __builtin_amdgcn_cvt_pk_fp8_f32(v0[0], v0[1], w0, false); w0 = __builtin_amdgcn_cvt_pk_fp8_f32(v0[2], v0[3], w0, true);
                    w1 = __builtin_amdgcn_cvt_pk_fp8_f32(v1[0], v1[1], w1, false); w1 = __builtin_amdgcn_cvt_pk_fp8_f32(v1[2], v1[3], w1, true);
                    w[2 * bj] = w0; w[2 * bj + 1] = w1; }
                *(u32x4*)rowp = (u32x4){(unsigned)w[0], (unsigned)w[1], (unsigned)w[2], (unsigned)w[3]}; }
    }
};
struct EpiRope {
    static constexpr bool PERM = true, AFTER_DRAIN = false, WIDE = false; static constexpr int NST = 16;
    bf16_t* O; int ldc; const float* rope;
    __device__ __forceinline__ void operator()(const f32x4 (&acc)[2][2][4][2], const Unit& u, int wr, int wc, int fr, int fq) const {
        const int row0 = u.pm * BM + wr * 64 + fr; const int col0 = u.pn * BM + wc * 32 + 8 * fq; const int fi = 16 * (wc & 1) + 4 * fq;
#pragma unroll
        for (int ai = 0; ai < 2; ++ai)
#pragma unroll
            for (int m = 0; m < 4; ++m) { const int row = row0 + ai * HALF + m * 16, pos = row & 2047; bf16_t* rowp = O + (size_t)row * ldc + col0;
                const f32x4 cs = *(const f32x4*)(rope + pos * 32 + fi), sn = *(const f32x4*)(rope + 65536 + pos * 32 + fi);
#pragma unroll
                for (int bj = 0; bj < 2; ++bj) { const int cb = u.pn * BM + bj * HALF; const bool rp = cb < 1024 || (cb >= 1536 && cb <= 2048); const float qs = (cb < 512 || (cb >= 1536 && cb < 2048)) ? 0.18033688011112042f : 1.f;
                    f32x4 v0 = acc[ai][bj][m][0], v1 = acc[ai][bj][m][1];
                    if (rp) { const f32x4 a = (v0 * cs - v1 * sn) * qs, b = (v1 * cs + v0 * sn) * qs; v0 = a; v1 = b; }
                    u32x4 w; w.x = cvt_pk_bf16(v0[0], v0[1]); w.y = cvt_pk_bf16(v0[2], v0[3]); w.z = cvt_pk_bf16(v1[0], v1[1]); w.w = cvt_pk_bf16(v1[2], v1[3]);
                    __builtin_nontemporal_store(w, (u32x4*)(rowp + bj * HALF)); } }
    }
};
struct EpiResid {
    static constexpr bool PERM = true, AFTER_DRAIN = false, WIDE = false; static constexpr int NST = 16;
    const float* x; bf16_t* out; const float* mod;
    __device__ __forceinline__ void operator()(const f32x4 (&acc)[2][2][4][2], const Unit& u, int wr, int wc, int fr, int fq) const {
        const int row0 = u.pm * BM + wr * 64 + fr; const int col0 = u.pn * BM + wc * 32 + 8 * fq; const float* gtp = mod + ((u.pm * BM) >> 11) * 6144 + 2048 + col0;
        f32x4 gt[2][2];
#pragma unroll
        for (int bj = 0; bj < 2; ++bj) { gt[bj][0] = *(const f32x4*)(gtp + bj * HALF); gt[bj][1] = *(const f32x4*)(gtp + bj * HALF + 4); }
#pragma unroll
        for (int ai = 0; ai < 2; ++ai)
#pragma unroll
            for (int m = 0; m < 4; ++m) { const size_t off = (size_t)(row0 + ai * HALF + m * 16) * 1024 + col0;
#pragma unroll
                for (int bj = 0; bj < 2; ++bj) { const f32x4 x0 = __builtin_nontemporal_load((const f32x4*)(x + off + bj * HALF)), x1 = __builtin_nontemporal_load((const f32x4*)(x + off + bj * HALF + 4));
                    const f32x4 v0 = x0 + gt[bj][0] * acc[ai][bj][m][0], v1 = x1 + gt[bj][1] * acc[ai][bj][m][1];
                    u32x4 w; w.x = cvt_pk_bf16(v0[0], v0[1]); w.y = cvt_pk_bf16(v0[2], v0[3]); w.z = cvt_pk_bf16(v1[0], v1[1]); w.w = cvt_pk_bf16(v1[2], v1[3]);
                    *(u32x4*)(out + off + bj * HALF) = w; } }
    }
};
struct EpiSwiGLU {
    static constexpr bool PERM = true, AFTER_DRAIN = false, WIDE = true; static constexpr int NST = 8;
    unsigned char* O;
    __device__ __forceinline__ void operator()(const f32x4 (&acc)[2][2][4][2], const Unit& u, int wr, int wc, int fr, int fq) const {
        const int row0 = u.pm * BM + wr * 64 + fr; const int col0 = u.pn * 128 + wc * 32 + 8 * fq;
#pragma unroll
        for (int ai = 0; ai < 2; ++ai)
#pragma unroll
            for (int m = 0; m < 4; ++m) { unsigned char* rowp = O + (size_t)(row0 + ai * HALF + m * 16) * 512 + col0; int w[2];
#pragma unroll
                for (int bj = 0; bj < 2; ++bj) { const f32x4 gv = acc[ai][bj][m][0], uv = acc[ai][bj][m][1]; f32x4 a;
#pragma unroll
                    for (int j = 0; j < 4; ++j) { const float t = gv[j] * __builtin_amdgcn_rcpf(1.f + __builtin_amdgcn_exp2f(-1.4426950408889634f * gv[j])) * uv[j]; a[j] = __builtin_fminf(__builtin_fmaxf(t, -448.f), 448.f); }
                    int ww = 0; ww = __builtin_amdgcn_cvt_pk_fp8_f32(a[0], a[1], ww, false); ww = __builtin_amdgcn_cvt_pk_fp8_f32(a[2], a[3], ww, true); w[bj] = ww; }
                *(u32x2*)rowp = (u32x2){(unsigned)w[0], (unsigned)w[1]}; }
    }
};
struct MoeOrder {
    int nN, G, c, R; const PG8_LAS int* tstart;
    __device__ __forceinline__ bool next(int i, Unit& u) const {
        int rt, pn;
        if (G == 256 && nN == 4) { rt = i * 64 + (c >> 5) * 8 + (c & 7); pn = (c & 31) >> 3; if (rt >= R) return false; }
        else { const long L = (long)i * G + c; if (L >= (long)R * nN) return false; rt = (int)(L / nN); pn = (int)(L % nN); }
        u.pn = pn; u.pm = rt; int e = 0;
#pragma unroll
        for (int k = 1; k < 16; ++k) e += (rt >= tstart[k]) ? 1 : 0;
        u.e = __builtin_amdgcn_readfirstlane(e); return true;
    }
    __device__ __forceinline__ void a_ready(const Unit&) const {}
    __device__ __forceinline__ void done(const Unit&) const {}
};
template <class Epi, class Sched, bool ALIGN_EPI = false, bool SP2 = false, bool GATHER = false, bool FP8 = false>
__device__ __forceinline__ void gemm_phase(PG8_LAS unsigned char* lds, const Gemm g, const Sched& S, const Epi& E, const int wid  , const PG8_LAS unsigned* gath = nullptr) {
    int lane; asm volatile("v_mbcnt_lo_u32_b32 %0, -1, 0\n\tv_mbcnt_hi_u32_b32 %0, -1, %0" : "=v"(lane));
    const int tid = wid * 64 + lane, wr = wid >> 2, wc = wid & 3, fr = lane & 15, fq = lane >> 4;
    const int K = g.K, nt = K / BK;
    unsigned voffA[2], voffB[2], gC[2]; int gR[2];
#pragma unroll
    for (int i = 0; i < 2; ++i) { int R, C; stage_rc(tid * 16 + i * 8192, R, C); const int Rb = Epi::WIDE ? (64 * (R >> 5) + 16 * ((R >> 2) & 3) + 4 * ((R >> 4) & 1) + (R & 3)) : Epi::PERM ? ((R & ~31) + perm32(R & 31)) : R;
        voffA[i] = (unsigned)(R * K + C) * 2u; voffB[i] = (unsigned)(Rb * K + C) * 2u; gR[i] = R; gC[i] = (unsigned)C * 2u; }
    const unsigned kstep = (unsigned)(BK * 2);
    const unsigned hstep = (unsigned)HALF * (unsigned)K * 2u;
    const unsigned bhstep = Epi::WIDE ? 8u * (unsigned)K * 2u : hstep;
    const unsigned tstep = 2u * hstep;
    const char* const baseA = (const char*)g.A; const char* const baseB = (const char*)g.Bt;
    unsigned cv0[2], cv1[2], nv0[2], nv1[2];
#define PG8_GOFF(dst0, dst1, uidx) do { _Pragma("unroll") for (int _i = 0; _i < 2; ++_i) { if constexpr (GATHER) { dst0[_i] = gath[(uidx) * 256 + gR[_i]] + gC[_i]; dst1[_i] = gath[(uidx) * 256 + 128 + gR[_i]] + gC[_i]; } else { dst0[_i] = 0u; dst1[_i] = 0u; } } } while (0)
    const unsigned ldsw = (unsigned)wid * 1024u;
    const int aoff = lds_byte(wr * 64 + fr, fq * (FP8 ? 16 : 8)), boff = lds_byte(wc * 32 + fr, fq * (FP8 ? 16 : 8));

#define PG8_SA(b, h) (((b) * 2 + (h)) * HTB)
#define PG8_SB(b, h) ((4 + (b) * 2 + (h)) * HTB)
#define PG8_STAGE(bufoff, BASE, goff, voff) do { _Pragma("unroll") for (int _i = 0; _i < 2; ++_i) \
        __builtin_amdgcn_global_load_lds((const unsigned*)((BASE) + (unsigned)((goff) + (voff)[_i])), (PG8_LAS unsigned*)(lds + (bufoff) + ldsw + _i * 8192), 16, 0, 0); } while (0)
#define PG8_RD8(p_) __builtin_shufflevector(*(const PG8_LAS v4i_t*)(p_), *(const PG8_LAS v4i_t*)((p_) + 16), 0, 1, 2, 3, 4, 5, 6, 7)
#define PG8_STA(bufoff, gbase, H, X0, X1) do { if constexpr (GATHER) { PG8_STAGE(bufoff, baseA, gbase, (H ? X1 : X0)); } else { PG8_STAGE(bufoff, baseA, (gbase) + (H ? hstep : 0u), voffA); } } while (0)
#define PG8_LDA(dst, b, h) do { if constexpr (FP8) { _Pragma("unroll") for (int m = 0; m < 4; ++m) dst##8[m] = PG8_RD8(lds + PG8_SA(b, h) + aoff + m * 2048); } \
        else { _Pragma("unroll") for (int m = 0; m < 4; ++m) _Pragma("unroll") for (int k = 0; k < 2; ++k) dst[m][k] = *(const PG8_LAS bf16x8*)(lds + PG8_SA(b, h) + aoff + m * 2048 + k * 1024); } } while (0)
#define PG8_LDB(dst, b, h) do { if constexpr (FP8) { _Pragma("unroll") for (int n = 0; n < 2; ++n) dst##8[n] = PG8_RD8(lds + PG8_SB(b, h) + boff + n * 2048); } \
        else { _Pragma("unroll") for (int n = 0; n < 2; ++n) _Pragma("unroll") for (int k = 0; k < 2; ++k) dst[n][k] = *(const PG8_LAS bf16x8*)(lds + PG8_SB(b, h) + boff + n * 2048 + k * 1024); } } while (0)
#define PG8_MMA(ai, bj, At, Bt) do { __builtin_amdgcn_s_setprio(1); \
        if constexpr (FP8) { _Pragma("unroll") for (int m = 0; m < 4; ++m) _Pragma("unroll") for (int n = 0; n < 2; ++n) \
            acc[ai][bj][m][n] = __builtin_amdgcn_mfma_scale_f32_16x16x128_f8f6f4(Bt##8[n], At##8[m], acc[ai][bj][m][n], 0, 0, 0, scl, 1, scl); \
          _Pragma("unroll") for (int m = 0; m < 4; ++m) _Pragma("unroll") for (int n = 0; n < 2; ++n) asm volatile("" : "+v"(acc[ai][bj][m][n])); }   \
        else { _Pragma("unroll") for (int m = 0; m < 4; ++m) _Pragma("unroll") for (int n = 0; n < 2; ++n) _Pragma("unroll") for (int k = 0; k < 2; ++k) \
            acc[ai][bj][m][n] = __builtin_amdgcn_mfma_f32_16x16x32_bf16(Bt[n][k], At[m][k], acc[ai][bj][m][n], 0, 0, 0); } \
        __builtin_amdgcn_s_setprio(0); } while (0)
#define PG8_WAIT_V(n) asm volatile("s_waitcnt vmcnt(" #n ")" ::: "memory")
#define PG8_WAIT_L(n) asm volatile("s_waitcnt lgkmcnt(" #n ")" ::: "memory")
#define PG8_BAR __builtin_amdgcn_s_barrier()
#define PG8_SCHED __builtin_amdgcn_sched_barrier(0)
    Unit cur, nxt; int ui = 0;
    if (!S.next(0, cur)) return;
    f32x4 acc[2][2][4][2];
#pragma unroll
    for (int a = 0; a < 2; ++a)
#pragma unroll
        for (int b = 0; b < 2; ++b)
#pragma unroll
            for (int m = 0; m < 4; ++m)
#pragma unroll
                for (int n = 0; n < 2; ++n) acc[a][b][m][n] = (f32x4){0.f, 0.f, 0.f, 0.f};
    int scl = 0x7f7a; asm volatile("" : "+v"(scl));
    bf16x8 At[4][2], B0[2][2], B1[2][2]; v8i_t At8[4], B08[2], B18[2];
    unsigned cA = GATHER ? 0u : (unsigned)cur.pm * tstep; PG8_GOFF(cv0, cv1, 0); unsigned cB = (unsigned)cur.e * (unsigned)g.bstride + (unsigned)cur.pn * tstep;
    S.a_ready(cur);
    if constexpr (SP2) {
        PG8_STAGE(PG8_SB(0, 0), baseB, cB, voffB); PG8_STAGE(PG8_SB(0, 1), baseB, cB + bhstep, voffB); PG8_STA(PG8_SA(0, 0), cA, 0, cv0, cv1); PG8_STA(PG8_SA(0, 1), cA, 1, cv0, cv1);
        if (wr == 1) PG8_BAR;
        PG8_WAIT_V(2); PG8_BAR;
        PG8_STAGE(PG8_SB(1, 0), baseB, cB + kstep, voffB); PG8_STA(PG8_SA(1, 0), cA + kstep, 0, cv0, cv1); PG8_STAGE(PG8_SB(1, 1), baseB, cB + bhstep + kstep, voffB); PG8_STA(PG8_SA(1, 1), cA + kstep, 1, cv0, cv1);
        PG8_WAIT_V(0); PG8_BAR;
    } else {
        PG8_STAGE(PG8_SB(0, 0), baseB, cB, voffB); PG8_STA(PG8_SA(0, 0), cA, 0, cv0, cv1); PG8_STAGE(PG8_SB(0, 1), baseB, cB + bhstep, voffB); PG8_STA(PG8_SA(0, 1), cA, 1, cv0, cv1);
        if (wr == 1) PG8_BAR;
        PG8_WAIT_V(4); PG8_BAR;
        PG8_STAGE(PG8_SB(1, 0), baseB, cB + kstep, voffB); PG8_STA(PG8_SA(1, 0), cA + kstep, 0, cv0, cv1); PG8_STAGE(PG8_SB(1, 1), baseB, cB + bhstep + kstep, voffB);
        PG8_WAIT_V(6); PG8_BAR;
    }
    for (;;) {
        const bool has_next = S.next(ui + 1, nxt);
        const unsigned nA = (has_next && !GATHER) ? (unsigned)nxt.pm * tstep : cA; if (has_next) { PG8_GOFF(nv0, nv1, ui + 1); } else { _Pragma("unroll") for (int _i = 0; _i < 2; ++_i) { nv0[_i] = cv0[_i]; nv1[_i] = cv1[_i]; } } const unsigned nB = has_next ? (unsigned)nxt.e * (unsigned)g.bstride + (unsigned)nxt.pn * tstep : cB;
        for (int t = 0; t < nt; t += 2) {
            const bool last = (t == nt - 2);
            const unsigned a1 = cA + (unsigned)(t + 1) * kstep;
            const unsigned a2 = last ? nA : cA + (unsigned)(t + 2) * kstep; const unsigned b2 = last ? nB : cB + (unsigned)(t + 2) * kstep;
            const unsigned a3 = a2 + kstep; const unsigned b3 = b2 + kstep;
            unsigned xA0[2], xA1[2];
#pragma unroll
            for (int _i = 0; _i < 2; ++_i) { xA0[_i] = (GATHER && last) ? nv0[_i] : cv0[_i]; xA1[_i] = (GATHER && last) ? nv1[_i] : cv1[_i]; }
            if (last && has_next) S.a_ready(nxt);
            if constexpr (SP2) {
            const bool fresh = (t == 0);
            PG8_LDB(B0, 0, 0); PG8_LDB(B1, 0, 1); PG8_SCHED; PG8_LDA(At, 0, 0); if (!fresh) PG8_STA(PG8_SA(1, 1), a1, 1, cv0, cv1);
            if (fresh) { if constexpr (Epi::NST == 16) PG8_WAIT_V(24); else PG8_WAIT_V(16); } else PG8_WAIT_V(8);
            PG8_WAIT_L(0); PG8_BAR; PG8_MMA(0, 0, At, B0); PG8_MMA(0, 1, At, B1); PG8_BAR; PG8_SCHED;
            PG8_LDA(At, 0, 1); PG8_STAGE(PG8_SB(0, 0), baseB, b2, voffB); PG8_STAGE(PG8_SB(0, 1), baseB, b2 + bhstep, voffB); PG8_STA(PG8_SA(0, 0), a2, 0, xA0, xA1);
            if (fresh) { if constexpr (Epi::NST == 16) PG8_WAIT_V(24); else PG8_WAIT_V(16); } else PG8_WAIT_V(8);
            PG8_WAIT_L(0); PG8_BAR; PG8_MMA(1, 0, At, B0); PG8_MMA(1, 1, At, B1); PG8_BAR; PG8_SCHED;
            PG8_LDB(B0, 1, 0); PG8_LDB(B1, 1, 1); PG8_SCHED; PG8_LDA(At, 1, 0); PG8_STA(PG8_SA(0, 1), a2, 1, xA0, xA1);
            if (fresh) { if constexpr (Epi::NST == 16) PG8_WAIT_V(24); else PG8_WAIT_V(16); } else PG8_WAIT_V(8);
            PG8_WAIT_L(0); PG8_BAR; PG8_MMA(0, 0, At, B0); PG8_MMA(0, 1, At, B1); PG8_BAR; PG8_SCHED;
            PG8_LDA(At, 1, 1); PG8_STAGE(PG8_SB(1, 0), baseB, b3, voffB); PG8_STAGE(PG8_SB(1, 1), baseB, b3 + bhstep, voffB); PG8_STA(PG8_SA(1, 0), a3, 0, xA0, xA1);
            PG8_WAIT_V(8); PG8_WAIT_L(0); PG8_BAR; PG8_MMA(1, 0, At, B0); PG8_MMA(1, 1, At, B1); PG8_BAR; PG8_SCHED;
            } else {
            PG8_LDB(B0, 0, 0); PG8_SCHED; PG8_LDA(At, 0, 0); PG8_STA(PG8_SA(1, 1), a1, 1, cv0, cv1);
            PG8_WAIT_L(8); PG8_BAR; PG8_WAIT_L(0); PG8_MMA(0, 0, At, B0); PG8_BAR; PG8_SCHED;
            PG8_LDB(B1, 0, 1); PG8_STAGE(PG8_SB(0, 0), baseB, b2, voffB);
            PG8_BAR; PG8_WAIT_L(0); PG8_MMA(0, 1, At, B1); PG8_BAR;
            PG8_LDA(At, 0, 1); PG8_STA(PG8_SA(0, 0), a2, 0, xA0, xA1);
            PG8_BAR; PG8_WAIT_L(0); PG8_MMA(1, 0, At, B0); PG8_BAR; PG8_SCHED;
            PG8_STAGE(PG8_SB(0, 1), baseB, b2 + bhstep, voffB);
            PG8_WAIT_V(6); PG8_BAR; PG8_MMA(1, 1, At, B1); PG8_BAR;
            PG8_LDB(B0, 1, 0); PG8_SCHED; PG8_LDA(At, 1, 0); PG8_STA(PG8_SA(0, 1), a2, 1, xA0, xA1);
            PG8_WAIT_L(8); PG8_BAR; PG8_WAIT_L(0); PG8_MMA(0, 0, At, B0); PG8_BAR; PG8_SCHED;
            PG8_LDB(B1, 1, 1); PG8_STAGE(PG8_SB(1, 0), baseB, b3, voffB);
            PG8_BAR; PG8_WAIT_L(0); PG8_MMA(0, 1, At, B1); PG8_BAR;
            PG8_LDA(At, 1, 1); PG8_STA(PG8_SA(1, 0), a3, 0, xA0, xA1);
            PG8_BAR; PG8_WAIT_L(0); PG8_MMA(1, 0, At, B0); PG8_BAR; PG8_SCHED;
            PG8_STAGE(PG8_SB(1, 1), baseB, b3 + bhstep, voffB);
            PG8_WAIT_V(6); PG8_BAR; PG8_MMA(1, 1, At, B1); PG8_BAR;
            }
        }
        if constexpr (SP2) { if (has_next) { if constexpr (GATHER) { PG8_STAGE(PG8_SA(1, 1), baseA, nA + kstep, nv1); } else { PG8_STAGE(PG8_SA(1, 1), baseA, nA + kstep + hstep, voffA); } } }
        if constexpr (ALIGN_EPI) { if (wr == 0) PG8_BAR; }
        if constexpr (!Epi::AFTER_DRAIN) { int l2; asm volatile("v_mbcnt_lo_u32_b32 %0, -1, 0\n\tv_mbcnt_hi_u32_b32 %0, -1, %0" : "=v"(l2)); E(acc, cur, wr, wc, l2 & 15, l2 >> 4); S.done(cur); }
        if (!has_next) break;
#pragma unroll
        for (int a = 0; a < 2; ++a)
#pragma unroll
            for (int b = 0; b < 2; ++b)
#pragma unroll
                for (int m = 0; m < 4; ++m)
#pragma unroll
                    for (int n = 0; n < 2; ++n) acc[a][b][m][n] = (f32x4){0.f, 0.f, 0.f, 0.f};
        cur = nxt; cA = nA; cB = nB; ++ui;
#pragma unroll
        for (int _i = 0; _i < 2; ++_i) { cv0[_i] = nv0[_i]; cv1[_i] = nv1[_i]; }
        if constexpr (ALIGN_EPI) { if (wr == 1) PG8_BAR; }
    }
    PG8_WAIT_V(0);
    if constexpr (!ALIGN_EPI) { if (wr == 0) PG8_BAR; }
    PG8_BAR;
    if constexpr (Epi::AFTER_DRAIN) { E.fused(acc, cur, wr, wc, fr, fq, lds, wid, lane); S.done(cur); }
#undef PG8_SA
#undef PG8_SB
#undef PG8_STAGE
#undef PG8_STA
#undef PG8_GOFF
#undef PG8_LDA
#undef PG8_LDB
#undef PG8_MMA
#undef PG8_RD8
#undef PG8_WAIT_V
#undef PG8_WAIT_L
#undef PG8_BAR
#undef PG8_SCHED
}
}

constexpr int NWAVES = 8;
#ifndef MK_ONE_LAUNCH
#define MK_ONE_LAUNCH 1
#endif
#ifndef MK_ATTN_NAIVE
#define MK_ATTN_NAIVE 0
#endif
constexpr int N_PHASES = 9;

constexpr int BATCH = 32, SEQ = 2048, D = 1024, T = BATCH * SEQ;
constexpr int NQKV = 2304, C_DQ = 0, C_DK = 512, C_DV = 1024, C_SQ = 1536, C_SK = 2048, C_SV = 2176;
constexpr int NEXP = 16, DEXP = 512;
constexpr int SORT_ROWS = 2 * T + NEXP * 256;
constexpr float EPS = 1e-6f;

constexpr size_t MiB = 1u << 20;
constexpr size_t WS_CTL = 0, CTL_ZERO_BYTES = 1 * MiB;
constexpr size_t WS_MOD = 1 * MiB;
constexpr size_t WS_ROPE = 2 * MiB;
constexpr size_t WS_TOK = 3 * MiB;
constexpr size_t WS_LIST = 5 * MiB;
constexpr size_t WS_WIN = 10 * MiB;
constexpr size_t WS_WO = 15 * MiB;
constexpr size_t WS_WGU = 17 * MiB;
constexpr size_t WS_WD = 49 * MiB;
constexpr size_t WS_ACT = 66 * MiB;
constexpr size_t WS_QKV = 194 * MiB;
constexpr size_t WS_GU = 482 * MiB;
constexpr size_t WS_ACTM = 746 * MiB;
constexpr size_t WS_END = 878 * MiB;
static_assert(WS_QKV + (size_t)T * NQKV * 2 <= WS_GU && WS_QKV + (size_t)SORT_ROWS * 1024 * 2 <= WS_GU && WS_GU + (size_t)SORT_ROWS * 1024 * 2 <= WS_ACTM && WS_GU + (size_t)T * 1024 * 4 <= WS_ACTM && WS_ACTM + (size_t)SORT_ROWS * 512 * 2 <= WS_END, "ws map");
constexpr int CW_CNT = 64;
constexpr int CW_BAR = 4096;
constexpr int CW_GMAP = 8192;
constexpr int CW_GB = 8448;

constexpr int RING_BYTES = 131072;
constexpr int MISC_OFF = RING_BYTES + 320;
constexpr int LDS_BYTES = 147456;

#define GAS __attribute__((address_space(1)))
#define LAS __attribute__((address_space(3)))
typedef unsigned short bf16;
typedef unsigned v4u __attribute__((ext_vector_type(4)));
typedef unsigned v2u __attribute__((ext_vector_type(2)));
typedef float f32x4 __attribute__((ext_vector_type(4)));
typedef float f32x2v __attribute__((ext_vector_type(2)));
#define RLX_AGENT __ATOMIC_RELAXED, __HIP_MEMORY_SCOPE_AGENT
#define LDS_WAIT() asm volatile("s_waitcnt lgkmcnt(0)" ::: "memory")
__device__ __forceinline__ unsigned f2bf(float f) { unsigned u = __builtin_bit_cast(unsigned, f); return (u + 0x7fffu + ((u >> 16) & 1u)) >> 16; }
__device__ __forceinline__ unsigned pk2(float lo, float hi) { return f2bf(lo) | (f2bf(hi) << 16); }
__device__ __forceinline__ float bflo(unsigned w) { return __builtin_bit_cast(float, w << 16); }
__device__ __forceinline__ float bfhi(unsigned w) { return __builtin_bit_cast(float, w & 0xffff0000u); }
__device__ __forceinline__ float wave_sum(float v) {
#pragma unroll
    for (int o = 1; o < 64; o <<= 1) v += __shfl_xor(v, o);
    return v;
}

#define XB_TMO      128
#define XB_XCNT(j)  (256  + 64 * (j))
#define XB_XSUB(j)  (1280 + 64 * (j))
#define XB_XGEN(j)  (2304 + 64 * (j))
#define XB_TOP      3328
#define XB_TOPGEN   3392
#define XCD_BAR_WORDS 3456
#define XB_SPIN_CAP (1u << 18)

__device__ __forceinline__ unsigned xb_ld(unsigned* p)              { return __hip_atomic_load(p, __ATOMIC_RELAXED, __HIP_MEMORY_SCOPE_AGENT); }
__device__ __forceinline__ unsigned xb_add(unsigned* p, unsigned v) { return __hip_atomic_fetch_add(p, v, __ATOMIC_RELAXED, __HIP_MEMORY_SCOPE_AGENT); }
__device__ __forceinline__ unsigned xb_xcc_id() { return (unsigned)__builtin_amdgcn_s_getreg((3 << 11) | 20) & 0xFu; }
#define XB_SPIN(cond, bar) do { unsigned _sp = 0; while (cond) { __builtin_amdgcn_s_sleep(1); \
    if ((++_sp & 255u) == 0u) { if (xb_ld(&(bar)[XB_TMO])) break; if (_sp > XB_SPIN_CAP) { atomicAdd(&(bar)[XB_TMO], 1u); break; } } } } while (0)

struct XcdBarrier {
    unsigned* bar; unsigned x;
    volatile LAS unsigned* st;
};

__device__ __forceinline__ XcdBarrier xcd_barrier_post(unsigned* bar, volatile LAS unsigned* st) {
    XcdBarrier b; b.bar = bar; b.x = xb_xcc_id(); b.st = st;
    if (threadIdx.x == 0) (void)xb_add(&bar[XB_XCNT(b.x)], 1u);
    return b;
}
__device__ __forceinline__ void xcd_barrier_complete(unsigned* bar, unsigned x, unsigned& nloc, unsigned& nx) {
    const unsigned G = gridDim.x * gridDim.y * gridDim.z;
    unsigned sum, cnt, mine, sp = 0u;
    for (;;) {
        sum = 0u; cnt = 0u; mine = 0u;
#pragma unroll
        for (unsigned j = 0; j < 16; ++j) { const unsigned c = xb_ld(&bar[XB_XCNT(j)]); sum += c; cnt += (c > 0u) ? 1u : 0u; mine = (j == x) ? c : mine; }
        if (sum == G) break;
        __builtin_amdgcn_s_sleep(1);
        if ((++sp & 255u) == 0u) { if (xb_ld(&bar[XB_TMO])) break; if (sp > XB_SPIN_CAP) { atomicAdd(&bar[XB_TMO], 1u); break; } }
    }
    nloc = mine > 0u ? mine : 1u; nx = cnt > 0u ? cnt : 1u;
}

__device__ __forceinline__ void xcd_barrier(const XcdBarrier& b) {
    asm volatile("s_waitcnt vmcnt(0)" ::: "memory");
    __syncthreads();
    if (threadIdx.x == 0) {
        unsigned* bar = b.bar;
        __builtin_amdgcn_s_waitcnt(0);
        unsigned nloc = b.st[0], nx = b.st[1];
        if (nloc == 0u) { xcd_barrier_complete(bar, b.x, nloc, nx); b.st[0] = nloc; b.st[1] = nx; }
        const unsigned old = xb_add(&bar[XB_XSUB(b.x)], 1u);
        const unsigned gen = old / nloc;
        if (old + 1u == (gen + 1u) * nloc) {
            __builtin_amdgcn_fence(__ATOMIC_RELEASE, "agent");
            asm volatile("s_waitcnt vmcnt(0)" ::: "memory");
            const unsigned og = xb_add(&bar[XB_TOP], 1u);
            const unsigned tg = og / nx;
            if (og + 1u == (tg + 1u) * nx) xb_add(&bar[XB_TOPGEN], 1u);
            else XB_SPIN(xb_ld(&bar[XB_TOPGEN]) == tg, bar);
            __builtin_amdgcn_fence(__ATOMIC_ACQUIRE, "agent");
            xb_add(&bar[XB_XGEN(b.x)], 1u);
            asm volatile("s_waitcnt vmcnt(0)" ::: "memory");
        } else {
            XB_SPIN(xb_ld(&bar[XB_XGEN(b.x)]) == gen, bar);
            __builtin_amdgcn_fence(__ATOMIC_ACQUIRE, "agent");
            asm volatile("s_waitcnt vmcnt(0)" ::: "memory");
        }
    }
    __syncthreads();
}


__device__ __forceinline__ void group_barrier(unsigned* ctl, unsigned* bar, int seam, int grp) {
    asm volatile("s_waitcnt vmcnt(0)" ::: "memory");
    __syncthreads();
    if (threadIdx.x == 0) {
        unsigned* c = ctl + CW_GB + (seam * 8 + grp) * 32;
        (void)xb_add(c, 1u);
        XB_SPIN(xb_ld(c) < 32u, bar);
        __builtin_amdgcn_fence(__ATOMIC_ACQUIRE, "agent");
        asm volatile("s_waitcnt vmcnt(0)" ::: "memory");
    }
    __syncthreads();
}

__device__ __forceinline__ int fresh_lane() { int l; asm volatile("v_mbcnt_lo_u32_b32 %0, -1, 0\n\tv_mbcnt_hi_u32_b32 %0, -1, %0" : "=v"(l)); return l; }
struct Frame {
    LAS unsigned char* lds;
    unsigned* ctl;
    int tid, lane, wave, G, bid;
    const float *x, *c, *w_ada, *b_ada, *g_mix, *w_in, *diff_lambda, *g_diff_sub, *swa_sinks, *w_out, *g_ffn, *w_rg, *b_rg, *w_re, *b_re, *w_gate, *w_up, *w_down, *g_final;
    float* out; unsigned char* ws;
    float* mod; float* rope;
    int *tok_e, *tok_r0, *tok_r1; float *tok_w0, *tok_w1; int* list;
    bf16 *WinT, *WoT, *ACT, *QKV, *X1; unsigned char *WguT, *WdT, *H8, *ACTM, *Y;
};

__device__ __forceinline__ int dst_row(int mode, int c) {
    if (mode == 1) { if (c < 1024 || (c >= 1536 && c < 2176)) { const int d = c & 63; return (c & ~63) + 32 * ((d >> 4) & 1) + 8 * ((d >> 2) & 3) + 4 * (d >> 5) + (d & 3); } return c; }
    if (mode >= 2) return 256 * (c >> 7) + 64 * ((c >> 5) & 3) + 16 * ((c >> 3) & 3) + 8 * ((c >> 2) & 1) + 4 * (mode - 2) + (c & 3);
    return c;
}
__device__ __forceinline__ void p0_transpose_item(const float* W, int K, int N, bf16* WT, int mode, LAS float* scr, int item, int lane) {
    const int nblk = N / 32, kb = item / nblk, nb = item % nblk, k0 = 64 * kb, n0 = 32 * nb;
#pragma unroll
    for (int i = 0; i < 32; ++i) { const int kk = 2 * i + (lane >> 5); scr[kk * 33 + (lane & 31)] = __builtin_nontemporal_load(W + (size_t)(k0 + kk) * N + n0 + (lane & 31)); }
    LDS_WAIT(); asm volatile("" ::: "memory");
    const int c = lane & 7;
#pragma unroll
    for (int j = 0; j < 4; ++j) { const int n = (lane >> 3) + 8 * j; const LAS float* s = scr + (8 * c) * 33 + n;
        v4u o; o.x = pk2(s[0 * 33], s[1 * 33]); o.y = pk2(s[2 * 33], s[3 * 33]); o.z = pk2(s[4 * 33], s[5 * 33]); o.w = pk2(s[6 * 33], s[7 * 33]);
        *(v4u*)(WT + (size_t)dst_row(mode, n0 + n) * K + k0 + 8 * c) = o; }
    LDS_WAIT(); asm volatile("" ::: "memory");
}

__device__ __forceinline__ void p0_transpose_item8(const float* W, int K, int N, unsigned char* WT, int mode, LAS float* scr, int item, int lane) {
    const int nblk = N / 32, kb = item / nblk, nb = item % nblk, k0 = 64 * kb, n0 = 32 * nb;
#pragma unroll
    for (int i = 0; i < 32; ++i) { const int kk = 2 * i + (lane >> 5); scr[kk * 33 + (lane & 31)] = __builtin_nontemporal_load(W + (size_t)(k0 + kk) * N + n0 + (lane & 31)) * 32.f; }
    LDS_WAIT(); asm volatile("" ::: "memory");
#pragma unroll
    for (int j = 0; j < 2; ++j) { const int idx = lane + 64 * j, n = idx >> 2, c = idx & 3; const LAS float* s = scr + (16 * c) * 33 + n;
        int w[4];
#pragma unroll
        for (int q = 0; q < 4; ++q) { int t = 0; t = __builtin_amdgcn_cvt_pk_fp8_f32(s[(4 * q) * 33], s[(4 * q + 1) * 33], t, false); t = __builtin_amdgcn_cvt_pk_fp8_f32(s[(4 * q + 2) * 33], s[(4 * q + 3) * 33], t, true); w[q] = t; }
        *(v4u*)(WT + (size_t)dst_row(mode, n0 + n) * K + k0 + 16 * c) = (v4u){(unsigned)w[0], (unsigned)w[1], (unsigned)w[2], (unsigned)w[3]}; }
    LDS_WAIT(); asm volatile("" ::: "memory");
}

__device__ __forceinline__ void ph_prologue(Frame& F) {
    const int gw = F.bid * NWAVES + F.wave, NGW = F.G * NWAVES;
    {
        typedef float f32x16 __attribute__((ext_vector_type(16)));
        const int n = F.lane & 31, ko = F.lane >> 5, nc = n < 24 ? n : 23;
        LAS float* red = (LAS float*)F.lds;
        const __amdgpu_buffer_rsrc_t wr = __builtin_amdgcn_make_buffer_rsrc((void*)F.w_ada, 0, 1024 * 6144 * 4, 0x00020000);
        for (int cb = F.bid; cb < 256; cb += F.G) {
            const int j0 = cb * 24;
            const int voff = ((128 * F.wave + 8 * ko) * 6144 + j0 + nc) * 4;
            float wv[8][8];
#pragma unroll
            for (int ks = 0; ks < 8; ++ks)
#pragma unroll
                for (int i = 0; i < 8; ++i) wv[ks][i] = __builtin_bit_cast(float, __builtin_amdgcn_raw_buffer_load_b32(wr, voff, (16 * ks + i) * 24576, 0));
            const float* cp = F.c + (size_t)n * 1024 + 128 * F.wave + 8 * ko;
            f32x16 acc = f32x16{};
#pragma unroll
            for (int ks = 0; ks < 8; ++ks) {
                const f32x4 c0 = *(const f32x4*)(cp + 16 * ks), c1 = *(const f32x4*)(cp + 16 * ks + 4);
                float s[8] = {c0.x, c0.y, c0.z, c0.w, c1.x, c1.y, c1.z, c1.w};
#pragma unroll
                for (int i = 0; i < 8; ++i) s[i] = s[i] * __builtin_amdgcn_rcpf(1.f + __expf(-s[i]));
                v4u sh, sl, ah, al;
#pragma unroll
                for (int q = 0; q < 4; ++q) {
                    const unsigned hs = pg8::cvt_pk_bf16(s[2 * q], s[2 * q + 1]); sh[q] = hs; sl[q] = pg8::cvt_pk_bf16(s[2 * q] - bflo(hs), s[2 * q + 1] - bfhi(hs));
                    const unsigned ha = pg8::cvt_pk_bf16(wv[ks][2 * q], wv[ks][2 * q + 1]); ah[q] = ha; al[q] = pg8::cvt_pk_bf16(wv[ks][2 * q] - bflo(ha), wv[ks][2 * q + 1] - bfhi(ha)); }
                acc = __builtin_amdgcn_mfma_f32_32x32x16_bf16(__builtin_bit_cast(pg8::bf16x8, ah), __builtin_bit_cast(pg8::bf16x8, sh), acc, 0, 0, 0);
                acc = __builtin_amdgcn_mfma_f32_32x32x16_bf16(__builtin_bit_cast(pg8::bf16x8, ah), __builtin_bit_cast(pg8::bf16x8, sl), acc, 0, 0, 0);
                acc = __builtin_amdgcn_mfma_f32_32x32x16_bf16(__builtin_bit_cast(pg8::bf16x8, al), __builtin_bit_cast(pg8::bf16x8, sh), acc, 0, 0, 0);
            }
#pragma unroll
            for (int r = 0; r < 16; ++r) red[(F.wave * 32 + 8 * (r >> 2) + 4 * ko + (r & 3)) * 32 + n] = acc[r];
            __syncthreads();
            for (int o = F.tid; o < 768; o += NWAVES * 64) { const int nn = o >> 5, bb = o & 31; float sum = 0.f;
#pragma unroll
                for (int w8 = 0; w8 < 8; ++w8) sum += red[(w8 * 32 + nn) * 32 + bb];
                F.mod[bb * 6144 + j0 + nn] = sum + F.b_ada[j0 + nn]; }
            __syncthreads();
        }
    }
    for (int i = F.bid * NWAVES * 64 + F.tid; i < SEQ * 32; i += F.G * NWAVES * 64) {
        const int pos = i >> 5, f = i & 31; const float inv = exp2f(-(float)f * (13.287712379549449f / 32.f)); const float ang = (float)pos * inv;
        F.rope[i] = cosf(ang); F.rope[SEQ * 32 + i] = sinf(ang); }
    LAS float* scr = (LAS float*)(F.lds + F.wave * 16384);
    constexpr int I_IN = 16 * 72, I_O = 16 * 32;
    for (int it = gw; it < I_IN + I_O; it += NGW) {
        if (it < I_IN) p0_transpose_item(F.w_in, 1024, NQKV, F.WinT, 1, scr, it, F.lane);
        else p0_transpose_item(F.w_out, 1024, 1024, F.WoT, 0, scr, it - I_IN, F.lane);
    }
}
__device__ __forceinline__ void expert_items(Frame& F, int k0, int k1) {
    const int gw = F.bid * NWAVES + F.wave, NGW = F.G * NWAVES;
    LAS float* scr = (LAS float*)(F.lds + F.wave * 16384);
    constexpr int I_G = 16 * 16 * 16, I_D = 16 * 8 * 32;
    for (int k = k0; k < k1; ++k) {
        int r = gw + k * NGW; if (r >= 2 * I_G + I_D) break;
        if (r < I_G) { const int e = r >> 8; p0_transpose_item8(F.w_gate + (size_t)e * 1024 * 512, 1024, 512, F.WguT + (size_t)e * 1024 * 1024, 2, scr, r & 255, F.lane); continue; } r -= I_G;
        if (r < I_G) { const int e = r >> 8; p0_transpose_item8(F.w_up + (size_t)e * 1024 * 512, 1024, 512, F.WguT + (size_t)e * 1024 * 1024, 3, scr, r & 255, F.lane); continue; } r -= I_G;
        { const int e = r >> 8; p0_transpose_item8(F.w_down + (size_t)e * 512 * 1024, 512, 1024, F.WdT + (size_t)e * 1024 * 512, 0, scr, r & 255, F.lane); }
    }
}

__device__ __forceinline__ void ph_norm1(Frame& F) {
    const int gw = F.bid * NWAVES + F.wave, NGW = F.G * NWAVES;
    const bool grpmap = (F.G == 256);
    const int mstart = grpmap ? 8192 * (F.bid & 7) + 4 * ((F.bid >> 3) * NWAVES + F.wave) : gw * 4, mstep = grpmap ? 1024 : NGW * 4, mend = grpmap ? 8192 * (F.bid & 7) + 8192 : T;
    for (int m0 = mstart; m0 < mend; m0 += mstep) {
        const int b = m0 >> 11;
        f32x4 v[4][4]; float s[4];
#pragma unroll
        for (int r = 0; r < 4; ++r) { const f32x4* xr = (const f32x4*)(F.x + (size_t)(m0 + r) * D) + F.lane;
#pragma unroll
            for (int j = 0; j < 4; ++j) v[r][j] = __builtin_nontemporal_load(xr + 64 * j); }
#pragma unroll
        for (int r = 0; r < 4; ++r) { float a = 0.f;
#pragma unroll
            for (int j = 0; j < 4; ++j) a += (v[r][j].x * v[r][j].x + v[r][j].y * v[r][j].y) + (v[r][j].z * v[r][j].z + v[r][j].w * v[r][j].w);
            s[r] = 1.f / sqrtf(wave_sum(a) * (1.f / D) + EPS); }
        const float* mb = F.mod + b * 6144;
#pragma unroll
        for (int j = 0; j < 4; ++j) { const int col = F.lane * 4 + 256 * j;
            const f32x4 g = *(const f32x4*)(F.g_mix + col), sh = *(const f32x4*)(mb + col), sc = *(const f32x4*)(mb + 1024 + col);
            const f32x4 gs = g * (sc + 1.f);
#pragma unroll
            for (int r = 0; r < 4; ++r) { const f32x4 a = v[r][j] * s[r] * gs + sh;
                *((unsigned long long*)(F.ACT + (size_t)(m0 + r) * D) + F.lane + 64 * j) = (unsigned long long)pk2(a.x, a.y) | ((unsigned long long)pk2(a.z, a.w) << 32); } }
    }
}

__device__ __forceinline__ float diff_lambda_value(Frame& F) {
    const float a = F.diff_lambda[F.lane] * F.diff_lambda[64 + F.lane], b = F.diff_lambda[128 + F.lane] * F.diff_lambda[192 + F.lane];
    return __expf(wave_sum(a)) - __expf(wave_sum(b)) + 0.2f;
}
template <int CTRL> __device__ __forceinline__ float dpp_add(float v) { return v + __builtin_bit_cast(float, __builtin_amdgcn_update_dpp(0, __builtin_bit_cast(int, v), CTRL, 0xf, 0xf, true)); }
__device__ __forceinline__ float wave_allsum(float v) {
    v = dpp_add<0xB1>(v); v = dpp_add<0x4E>(v); v = dpp_add<0x141>(v); v = dpp_add<0x140>(v);
    { const unsigned u = __float_as_uint(v); auto rr = __builtin_amdgcn_permlane16_swap(u, u, false, false); v = __uint_as_float(rr[0]) + __uint_as_float(rr[1]); }
    { const unsigned u = __float_as_uint(v); auto rr = __builtin_amdgcn_permlane32_swap(u, u, false, false); v = __uint_as_float(rr[0]) + __uint_as_float(rr[1]); }
    return v;
}
__device__ __forceinline__ float hsum4(f32x4 a) { return (a.x + a.y) + (a.z + a.w); }
__device__ __forceinline__ void ph_norm2_route(Frame& F) {
    LAS float* WrT = (LAS float*)F.lds;
    LAS int* rinfo = (LAS int*)(F.lds + 81920);
    LAS int* hist = (LAS int*)(F.lds + 81920 + 4096);
    for (int k = F.tid; k < 1024; k += NWAVES * 64) {
        const f32x4 g = *(const f32x4*)(F.w_rg + k * 4);
        WrT[0 * 1024 + k] = g.x; WrT[1 * 1024 + k] = g.y; WrT[2 * 1024 + k] = g.z; WrT[3 * 1024 + k] = g.w;
#pragma unroll
        for (int q = 0; q < 4; ++q) { const f32x4 e = *(const f32x4*)(F.w_re + k * 16 + 4 * q);
            WrT[(4 + 4 * q) * 1024 + k] = e.x; WrT[(5 + 4 * q) * 1024 + k] = e.y; WrT[(6 + 4 * q) * 1024 + k] = e.z; WrT[(7 + 4 * q) * 1024 + k] = e.w; }
    }
    const f32x4 brg = *(const f32x4*)F.b_rg;
    for (int chunk = (F.G == 256 ? (F.bid & 7) * 32 + (F.bid >> 3) : F.bid); chunk < T / 256; chunk += F.G) {
        if (F.tid < 32) hist[F.tid] = 0;
        __syncthreads();
        const int b = (chunk * 256) >> 11; const float* mb = F.mod + b * 6144;
        unsigned long long xq[4][4];
#pragma unroll
        for (int r = 0; r < 4; ++r) { const unsigned long long* xr = (const unsigned long long*)(F.X1 + (size_t)(chunk * 256 + F.wave * 32 + r) * D) + F.lane;
#pragma unroll
            for (int j = 0; j < 4; ++j) xq[r][j] = xr[64 * j]; }
        for (int rr = 0; rr < 32; rr += 4) {
            const int lt0 = F.wave * 32 + rr, m0 = chunk * 256 + lt0;
            f32x4 v[4][4]; float rs[4];
#pragma unroll
            for (int r = 0; r < 4; ++r)
#pragma unroll
                for (int j = 0; j < 4; ++j) { const unsigned long long w = xq[r][j]; const unsigned lo = (unsigned)w, hi = (unsigned)(w >> 32); v[r][j] = (f32x4){bflo(lo), bfhi(lo), bflo(hi), bfhi(hi)}; }
            if (rr + 4 < 32) {
#pragma unroll
                for (int r = 0; r < 4; ++r) { const unsigned long long* xr = (const unsigned long long*)(F.X1 + (size_t)(m0 + 4 + r) * D) + F.lane;
#pragma unroll
                    for (int j = 0; j < 4; ++j) xq[r][j] = xr[64 * j]; } }
#pragma unroll
            for (int r = 0; r < 4; ++r) { f32x4 a = v[r][0] * v[r][0];
#pragma unroll
                for (int j = 1; j < 4; ++j) a += v[r][j] * v[r][j];
                rs[r] = 1.f / sqrtf(wave_allsum(hsum4(a)) * (1.f / D) + EPS); }
#pragma unroll
            for (int j = 0; j < 4; ++j) { const int col = F.lane * 4 + 256 * j;
                const f32x4 g = *(const f32x4*)(F.g_ffn + col), sh = *(const f32x4*)(mb + 3072 + col), sc = *(const f32x4*)(mb + 4096 + col);
                const f32x4 gs = g * (sc + 1.f);
#pragma unroll
                for (int r = 0; r < 4; ++r) { v[r][j] = v[r][j] * rs[r] * gs + sh;
                    const f32x4 hc = __builtin_elementwise_min(__builtin_elementwise_max(v[r][j], (f32x4){-448.f, -448.f, -448.f, -448.f}), (f32x4){448.f, 448.f, 448.f, 448.f});
                    int w8 = 0; w8 = __builtin_amdgcn_cvt_pk_fp8_f32(hc.x, hc.y, w8, false); w8 = __builtin_amdgcn_cvt_pk_fp8_f32(hc.z, hc.w, w8, true);
                    *((int*)(F.H8 + (size_t)(m0 + r) * D) + F.lane + 64 * j) = w8; } }
            float gl[4][4];
#pragma unroll
            for (int c = 0; c < 4; ++c) { f32x4 a[4];
#pragma unroll
                for (int j = 0; j < 4; ++j) { const f32x4 w = *(const LAS f32x4*)(WrT + c * 1024 + F.lane * 4 + 256 * j);
#pragma unroll
                    for (int r = 0; r < 4; ++r) a[r] = (j == 0) ? v[r][j] * w : a[r] + v[r][j] * w; }
#pragma unroll
                for (int r = 0; r < 4; ++r) gl[r][c] = wave_allsum(hsum4(a[r])) + brg[c]; }
#pragma unroll
            for (int r = 0; r < 4; ++r) {
                int gi = 0; float gm = gl[r][0];
#pragma unroll
                for (int g = 1; g < 4; ++g) if (gl[r][g] > gm) { gm = gl[r][g]; gi = g; }
                gi = __builtin_amdgcn_readfirstlane(gi);
                float gsum = 0.f;
#pragma unroll
                for (int g = 0; g < 4; ++g) gsum += __expf(gl[r][g] - gm);
                const float grp_p = 1.f / gsum;
                const LAS float* We = WrT + (4 + 4 * gi) * 1024 + F.lane * 4;
                f32x4 ea[4];
#pragma unroll
                for (int j = 0; j < 4; ++j)
#pragma unroll
                    for (int i = 0; i < 4; ++i) { const f32x4 w = *(const LAS f32x4*)(We + i * 1024 + 256 * j); ea[i] = (j == 0) ? v[r][j] * w : ea[i] + v[r][j] * w; }
                const f32x4 bre = *(const f32x4*)(F.b_re + 4 * gi);
                float el[4];
#pragma unroll
                for (int i = 0; i < 4; ++i) el[i] = wave_allsum(hsum4(ea[i])) + bre[i];
                int i0 = 0; float m0v = el[0];
#pragma unroll
                for (int i = 1; i < 4; ++i) if (el[i] > m0v) { m0v = el[i]; i0 = i; }
                int i1 = -1; float m1v = -3.0e38f;
#pragma unroll
                for (int i = 0; i < 4; ++i) if (i != i0 && el[i] > m1v) { m1v = el[i]; i1 = i; }
                const float t = __expf(m1v - m0v); const float w0 = grp_p / (1.f + t), w1 = grp_p * t / (1.f + t);
                if (F.lane == 0) { const int lt = lt0 + r; rinfo[lt * 4 + 0] = gi * 4 + i0; rinfo[lt * 4 + 1] = gi * 4 + i1; rinfo[lt * 4 + 2] = __builtin_bit_cast(int, w0); rinfo[lt * 4 + 3] = __builtin_bit_cast(int, w1); }
            }
        }
        __syncthreads();
        int e0 = 0, e1 = 0, r0 = 0, r1 = 0;
        if (F.tid < 256) { e0 = rinfo[F.tid * 4]; e1 = rinfo[F.tid * 4 + 1]; r0 = __hip_atomic_fetch_add(&hist[e0], 1, __ATOMIC_RELAXED, __HIP_MEMORY_SCOPE_WORKGROUP); r1 = __hip_atomic_fetch_add(&hist[e1], 1, __ATOMIC_RELAXED, __HIP_MEMORY_SCOPE_WORKGROUP); }
        __syncthreads();
        if (F.tid < 16) hist[16 + F.tid] = (int)__hip_atomic_fetch_add(F.ctl + CW_CNT + F.tid, (unsigned)hist[F.tid], RLX_AGENT);
        __syncthreads();
        if (F.tid < 256) { const int m = chunk * 256 + F.tid; r0 += hist[16 + e0]; r1 += hist[16 + e1];
            F.list[e0 * T + r0] = m; F.list[e1 * T + r1] = m;
            F.tok_e[m] = e0 | (e1 << 8); F.tok_r0[m] = r0; F.tok_r1[m] = r1; F.tok_w0[m] = __builtin_bit_cast(float, rinfo[F.tid * 4 + 2]); F.tok_w1[m] = __builtin_bit_cast(float, rinfo[F.tid * 4 + 3]); }
        __syncthreads();
    }
}

__device__ __forceinline__ void load_tstart(Frame& F, LAS int* ts) {
    if (F.tid == 0) { int acc = 0;
        for (int e = 0; e < 16; ++e) { ts[e] = acc; const int n = (int)__hip_atomic_load(F.ctl + CW_CNT + e, RLX_AGENT); ts[32 + e] = n; acc += (n + 255) >> 8; }
        ts[16] = acc; }
    __syncthreads();
}

__device__ __forceinline__ void ph_final(Frame& F) {
    LAS int* ts = (LAS int*)(F.lds + RING_BYTES);
    load_tstart(F, ts);
    const int gw = F.bid * NWAVES + F.wave, NGW = F.G * NWAVES;
    for (int m0 = gw * 4; m0 < T; m0 += NGW * 4) {
        const int b = m0 >> 11; const float* mb = F.mod + b * 6144;
        const int mr = m0 + (F.lane & 3);
        const int ee = F.tok_e[mr]; const int e0 = ee & 255, e1 = ee >> 8;
        const unsigned q0 = 256u * (unsigned)ts[e0] + (unsigned)F.tok_r0[mr], q1 = 256u * (unsigned)ts[e1] + (unsigned)F.tok_r1[mr];
        const float w0l = F.tok_w0[mr], w1l = F.tok_w1[mr];
        f32x4 v[4][4]; unsigned ya[4][4], yb[4][4]; float w0[4], w1[4];
#pragma unroll
        for (int r = 0; r < 4; ++r) {
            const size_t p0 = (unsigned)__builtin_amdgcn_readlane((int)q0, r), p1 = (unsigned)__builtin_amdgcn_readlane((int)q1, r);
            w0[r] = __builtin_bit_cast(float, __builtin_amdgcn_readlane(__builtin_bit_cast(int, w0l), r)); w1[r] = __builtin_bit_cast(float, __builtin_amdgcn_readlane(__builtin_bit_cast(int, w1l), r));
            const unsigned long long* xr = (const unsigned long long*)(F.X1 + (size_t)(m0 + r) * D) + F.lane;
            const unsigned* y0 = (const unsigned*)(F.Y + p0 * D) + F.lane; const unsigned* y1 = (const unsigned*)(F.Y + p1 * D) + F.lane;
#pragma unroll
            for (int j = 0; j < 4; ++j) { const unsigned long long w = __builtin_nontemporal_load(xr + 64 * j); const unsigned lo = (unsigned)w, hi = (unsigned)(w >> 32); v[r][j] = (f32x4){bflo(lo), bfhi(lo), bflo(hi), bfhi(hi)}; ya[r][j] = __builtin_nontemporal_load(y0 + 64 * j); yb[r][j] = __builtin_nontemporal_load(y1 + 64 * j); }
        }
        float rs[4];
#pragma unroll
        for (int r = 0; r < 4; ++r) { float s = 0.f;
#pragma unroll
            for (int j = 0; j < 4; ++j) { const int col = F.lane * 4 + 256 * j; const f32x4 gt = *(const f32x4*)(mb + 5120 + col);
                const f32x2v a01 = __builtin_amdgcn_cvt_pk_f32_fp8((int)ya[r][j], false), a23 = __builtin_amdgcn_cvt_pk_f32_fp8((int)ya[r][j], true), c01 = __builtin_amdgcn_cvt_pk_f32_fp8((int)yb[r][j], false), c23 = __builtin_amdgcn_cvt_pk_f32_fp8((int)yb[r][j], true);
                v[r][j].x += gt.x * (w0[r] * a01.x + w1[r] * c01.x); v[r][j].y += gt.y * (w0[r] * a01.y + w1[r] * c01.y); v[r][j].z += gt.z * (w0[r] * a23.x + w1[r] * c23.x); v[r][j].w += gt.w * (w0[r] * a23.y + w1[r] * c23.y);
                s += (v[r][j].x * v[r][j].x + v[r][j].y * v[r][j].y) + (v[r][j].z * v[r][j].z + v[r][j].w * v[r][j].w); }
            rs[r] = 1.f / sqrtf(wave_sum(s) * (1.f / D) + EPS); }
#pragma unroll
        for (int j = 0; j < 4; ++j) { const int col = F.lane * 4 + 256 * j; const f32x4 g = *(const f32x4*)(F.g_final + col);
#pragma unroll
            for (int r = 0; r < 4; ++r) __builtin_nontemporal_store(v[r][j] * rs[r] * g, (f32x4*)(F.out + (size_t)(m0 + r) * D) + F.lane + 64 * j); }
    }
}


namespace fa {
typedef short bf16x8 __attribute__((ext_vector_type(8)));
typedef short s16x4 __attribute__((ext_vector_type(4)));
typedef short v4i16_t __attribute__((ext_vector_type(4)));
typedef float f32x16 __attribute__((ext_vector_type(16)));
typedef float f32x2_t __attribute__((ext_vector_type(2))); typedef __bf16 bf16x2_t __attribute__((ext_vector_type(2)));
typedef LAS const char* lds_cptr;
constexpr float LOG2E = 1.4426950408889634f;
constexpr float QSCALE = 0.125f * LOG2E;
#define FA_THR 8.0f
__device__ __forceinline__ int crow(int r, int hi) { return (r & 3) + 8 * (r >> 2) + 4 * hi; }
__device__ __forceinline__ unsigned cvtpk(float lo, float hi) { f32x2_t v = {lo, hi}; bf16x2_t b = __builtin_convertvector(v, bf16x2_t); return __builtin_bit_cast(unsigned, b); }
__device__ __forceinline__ s16x4 vtr(lds_cptr p) { return __builtin_bit_cast(s16x4, __builtin_amdgcn_ds_read_tr16_b64_v4i16((LAS v4i16_t*)p)); }
__device__ __forceinline__ float xmax(float v) { auto rr = __builtin_amdgcn_permlane32_swap(__float_as_uint(v), __float_as_uint(v), false, false); return fmaxf(__uint_as_float(rr[0]), __uint_as_float(rr[1])); }
__device__ __forceinline__ float xsum(float v) { auto rr = __builtin_amdgcn_permlane32_swap(__float_as_uint(v), __float_as_uint(v), false, false); return __uint_as_float(rr[0]) + __uint_as_float(rr[1]); }

__device__ __forceinline__ void glds16(const void* gsrc, unsigned lds_dst) { unsigned keep;
    asm volatile("s_mov_b32 %0, m0\n\ts_mov_b32 m0, %2\n\ts_nop 0\n\tglobal_load_lds_dwordx4 %1, off\n\ts_mov_b32 m0, %0" : "=&s"(keep) : "v"(gsrc), "s"(lds_dst) : "memory"); }
__device__ __forceinline__ void glds16o(const void* sbase, unsigned voff, unsigned lds_dst) { unsigned keep;
    asm volatile("s_mov_b32 %0, m0\n\ts_mov_b32 m0, %3\n\ts_nop 0\n\tglobal_load_lds_dwordx4 %1, %2\n\ts_mov_b32 m0, %0" : "=&s"(keep) : "v"(voff), "s"(sbase), "s"(lds_dst) : "memory"); }
__device__ __forceinline__ float max3f(float a, float b, float c) { float r; asm("v_max3_f32 %0, %1, %2, %3" : "=v"(r) : "v"(a), "v"(b), "v"(c)); return r; }
template <bool SWA>
__device__ __forceinline__ void attn_unit(Frame& F, int b_first, int hh_first, int q0_first, float lam, int nblk) {
    constexpr int NDB = SWA ? 2 : 4;
    constexpr int KSL = SWA ? 8192 : 16384, VSL = SWA ? 8192 : 16384, NSL = 4, VRING = NSL * KSL, OPS = SWA ? 1 : 2;
    const int lane = F.lane, wid = F.wave, r32 = lane & 31, hi = lane >> 5;
    const int sub = wid >> 2, rw = wid & 3, grp = wid >> 2;
#define FA_COORD(i_, b_, hh_, q0_) do { if (SWA) { b_ = b_first; hh_ = hh_first; q0_ = q0_first + 64 * (i_); } else if (nblk == 1) { b_ = b_first; hh_ = hh_first; q0_ = q0_first; } \
        else { const int pr_ = (F.bid & 7) * 16 + 2 * (i_) + (F.bid >> 7), j_ = (F.bid >> 3) & 15; b_ = pr_ >> 2; hh_ = pr_ & 3; q0_ = 128 * (((i_) & 1) ? 15 - j_ : j_); } } while (0)
#define FA_QPTR(b_, hh_, q0_) (F.QKV + (size_t)(b_) * SEQ * NQKV + (size_t)((SWA ? (q0_) + 32 * (wid & 1) : (q0_) + 32 * rw) + r32) * NQKV + (SWA ? C_SQ + ((hh_) * 4 + (wid >> 1)) * 64 : C_DQ + (hh_) * 128 + sub * 64) + hi * 8)
    bf16x8 qn[4];
    if (SWA) { int b0_, h0_, q00_; FA_COORD(0, b0_, h0_, q00_); const bf16* qp_ = FA_QPTR(b0_, h0_, q00_);
#pragma unroll
      for (int s = 0; s < 4; ++s) qn[s] = *(const bf16x8*)(qp_ + s * 16); }
    const int krow = 8 * wid + (lane >> 3);
    LAS unsigned char* L = F.lds; const unsigned lds0 = (unsigned)(uintptr_t)L;
#define FA_GLDS(src, dstoff) glds16o(F.QKV, (src), (unsigned)__builtin_amdgcn_readfirstlane((int)(lds0 + (unsigned)(dstoff))))
#define FA_ISSUE_K(t, sl) do { const unsigned to_ = (unsigned)(t) * (64u * NQKV * 2u); const int sb_ = (sl) * KSL; \
        FA_GLDS(ksrc1 + to_, sb_ + wid * 1024); if (!SWA) FA_GLDS(ksrc1 + 128u + to_, sb_ + 8192 + wid * 1024); } while (0)
#define FA_ISSUE_V(t, sl) do { const unsigned to_ = (unsigned)(t) * (64u * NQKV * 2u); const int sb_ = VRING + (sl) * VSL; \
        FA_GLDS(vsrcA + to_, sb_ + wid * 1024); if (!SWA) FA_GLDS(vsrcA + 128u + to_, sb_ + (wid + 8) * 1024); } while (0)
    const int vq_ = (lane & 15) >> 2, vcl_ = 2 * ((lane >> 4) & 1) + ((lane & 3) >> 1);
    const lds_cptr vpl0 = (lds_cptr)(L + VRING) + (4 * hi + vq_) * 128 + (((4 * (vq_ >> 1)) + vcl_) * 16) + 8 * (lane & 1);
    const lds_cptr vpl1 = (lds_cptr)(L + VRING) + (4 * hi + vq_) * 128 + (((4 * (1 - (vq_ >> 1))) + vcl_) * 16) + 8 * (lane & 1);
    const lds_cptr kpl = (lds_cptr)L + (SWA ? 0 : sub * 8192) + r32 * 128;
    int koff[4];
#pragma unroll
    for (int s = 0; s < 4; ++s) koff[s] = ((2 * s + hi) ^ ((r32 >> 1) & 7)) << 4;
#pragma unroll 1
  for (int blk = 0; blk < nblk; ++blk) {
    int b, hh, q0; FA_COORD(blk, b, hh, q0);
    const bool pref = !SWA && blk > 0;
    const int t0 = SWA ? (q0 >= 128 ? (q0 >> 6) - 2 : 0) : 0, t1 = SWA ? (q0 >> 6) + 1 : (q0 >> 6) + 2;
    const int qrow0 = SWA ? q0 + 32 * (wid & 1) : q0 + 32 * rw;
    const int hq = hh * 4 + (wid >> 1);
    const bool moreq = SWA && (blk + 1 < nblk), more = moreq;
    const bf16* rowbase = F.QKV + (size_t)b * SEQ * NQKV;
    const unsigned ksrc1 = (unsigned)(((size_t)b * SEQ + krow) * NQKV + (SWA ? C_SK + hh * 64 : C_DK + hh * 128) + (((lane & 7) ^ ((krow >> 1) & 7)) * 8)) * 2u;
    const unsigned vsrcA = (unsigned)(((size_t)b * SEQ + krow) * NQKV + (SWA ? C_SV + hh * 64 : C_DV + hh * 128) + (((lane & 7) ^ (((krow >> 1) & 1) << 2)) * 8)) * 2u;
    bf16x8 qr[4];
    if (SWA) {
#pragma unroll
        for (int s = 0; s < 4; ++s) qr[s] = qn[s]; }
    else if (pref) { asm volatile("" : "+v"(qn[0]), "+v"(qn[1]), "+v"(qn[2]), "+v"(qn[3]));
#pragma unroll
        for (int s = 0; s < 4; ++s) qr[s] = qn[s]; }
    else { const bf16* qp_ = FA_QPTR(b, hh, q0);
#pragma unroll
        for (int s = 0; s < 4; ++s) qr[s] = *(const bf16x8*)(qp_ + s * 16); }
    if (moreq) { int nb_, nh_, nq_; FA_COORD(blk + 1, nb_, nh_, nq_); const bf16* qp_ = FA_QPTR(nb_, nh_, nq_);
#pragma unroll
        for (int s = 0; s < 4; ++s) qn[s] = *(const bf16x8*)(qp_ + s * 16); }
    f32x16 o[NDB];
#pragma unroll
    for (int d = 0; d < NDB; ++d) o[d] = f32x16{};
    f32x16 p0 = f32x16{}, p1 = f32x16{};
    v4u pw[4] = {};
    float m = 0.f, l = 0.f; bool unset = true;
    f32x16 negm = f32x16{};
    const int qg = qrow0 + r32;
    const int nt = t1 - t0;
    if (!SWA) { if (!pref) { FA_ISSUE_K(t0, 0); if (1 < nt) FA_ISSUE_K(t0 + 1, 1); if (2 < nt) FA_ISSUE_K(t0 + 2, 2); FA_ISSUE_V(t0, 0); } }
    else if (blk == 0) { for (int tt = t0; tt < t1; ++tt) { FA_ISSUE_K(tt, tt & 3); FA_ISSUE_V(tt, tt & 3); } }
#define FA_SB() __builtin_amdgcn_sched_barrier(0)
#define FA_SLOT(t_) (((SWA ? t0 : 0) + (t_)) & 3)
#define FA_VREAD(X, d_) do { const lds_cptr vq = (((d_) & 1) ? vp1 : vp0) + ((d_) >> 1) * 8192; _Pragma("unroll") for (int ks = 0; ks < 4; ++ks) { X##l[ks] = vtr(vq + ks * 2048); X##h[ks] = vtr(vq + ks * 2048 + 1024); } } while (0)
#define FA_VMMA(X, d_) do { _Pragma("unroll") for (int ks = 0; ks < 4; ++ks) { const bf16x8 va_ = (bf16x8){X##l[ks][0], X##l[ks][1], X##l[ks][2], X##l[ks][3], X##h[ks][0], X##h[ks][1], X##h[ks][2], X##h[ks][3]}; \
                o[d_] = __builtin_amdgcn_mfma_f32_32x32x16_bf16(va_, __builtin_bit_cast(bf16x8, pw[ks]), o[d_], 0, 0, 0); } } while (0)
#define FA_PV(t_) do { const lds_cptr vp0 = vpl0 + FA_SLOT(t_) * VSL, vp1 = vpl1 + FA_SLOT(t_) * VSL; s16x4 val[4], vah[4], vbl[4], vbh[4]; \
        FA_VREAD(va, 0); FA_SB(); FA_VREAD(vb, 1); FA_SB(); FA_VMMA(va, 0); FA_SB(); \
        if (NDB > 2) { FA_VREAD(va, 2); FA_SB(); } \
        FA_VMMA(vb, 1); FA_SB(); \
        if (NDB > 2) { FA_VREAD(vb, 3); FA_SB(); FA_VMMA(va, 2); FA_SB(); FA_VMMA(vb, 3); FA_SB(); } } while (0)
#define FA_QK(t_) do { const lds_cptr kp = kpl + FA_SLOT(t_) * KSL; bf16x8 ka[4], kb[4]; \
        _Pragma("unroll") for (int s = 0; s < 2; ++s) { ka[2 * s] = *(const LAS bf16x8*)(kp + koff[s]); ka[2 * s + 1] = *(const LAS bf16x8*)(kp + koff[s] + 4096); } \
        FA_SB(); \
        _Pragma("unroll") for (int s = 0; s < 2; ++s) { kb[2 * s] = *(const LAS bf16x8*)(kp + koff[s + 2]); kb[2 * s + 1] = *(const LAS bf16x8*)(kp + koff[s + 2] + 4096); } \
        FA_SB(); \
        p0 = __builtin_amdgcn_mfma_f32_32x32x16_bf16(ka[0], qr[0], negm, 0, 0, 0); p1 = __builtin_amdgcn_mfma_f32_32x32x16_bf16(ka[1], qr[0], negm, 0, 0, 0); \
        p0 = __builtin_amdgcn_mfma_f32_32x32x16_bf16(ka[2], qr[1], p0, 0, 0, 0); p1 = __builtin_amdgcn_mfma_f32_32x32x16_bf16(ka[3], qr[1], p1, 0, 0, 0); \
        FA_SB(); \
        p0 = __builtin_amdgcn_mfma_f32_32x32x16_bf16(kb[0], qr[2], p0, 0, 0, 0); p1 = __builtin_amdgcn_mfma_f32_32x32x16_bf16(kb[1], qr[2], p1, 0, 0, 0); \
        p0 = __builtin_amdgcn_mfma_f32_32x32x16_bf16(kb[2], qr[3], p0, 0, 0, 0); p1 = __builtin_amdgcn_mfma_f32_32x32x16_bf16(kb[3], qr[3], p1, 0, 0, 0); \
        FA_SB(); } while (0)
#define FA_SM(t_) do { const int tg = t0 + (t_); __builtin_amdgcn_s_setprio(2);   \
        if (SWA || (64 * tg + 63 > qrow0)) { \
            _Pragma("unroll") for (int r = 0; r < 16; ++r) { const int kv = 64 * tg + crow(r, hi); \
                const bool v0 = SWA ? (kv <= qg && qg - kv < 128) : (kv <= qg); \
                const bool v1 = SWA ? (kv + 32 <= qg && qg - kv - 32 < 128) : (kv + 32 <= qg); \
                p0[r] = v0 ? p0[r] : -1e30f; p1[r] = v1 ? p1[r] : -1e30f; } } \
        float mx = max3f(p0[0], p1[0], p0[1]); \
        mx = max3f(mx, p1[1], p0[2]); mx = max3f(mx, p1[2], p0[3]); mx = max3f(mx, p1[3], p0[4]); mx = max3f(mx, p1[4], p0[5]); mx = max3f(mx, p1[5], p0[6]); mx = max3f(mx, p1[6], p0[7]); \
        mx = max3f(mx, p1[7], p0[8]); mx = max3f(mx, p1[8], p0[9]); mx = max3f(mx, p1[9], p0[10]); mx = max3f(mx, p1[10], p0[11]); mx = max3f(mx, p1[11], p0[12]); mx = max3f(mx, p1[12], p0[13]); \
        mx = max3f(mx, p1[13], p0[14]); mx = max3f(mx, p1[14], p0[15]); mx = max3f(mx, p1[15], mx); \
        mx = xmax(mx); \
        { const bool rowvalid = mx > -1e29f; \
          if (__any(mx > FA_THR || (unset && rowvalid))) {                   \
            const float dl = rowvalid ? (unset ? mx : max3f(mx, 0.f, 0.f)) : 0.f, al = unset ? 1.f : __builtin_amdgcn_exp2f(-dl); \
            unset = unset && !rowvalid; m += dl; l *= al; \
            _Pragma("unroll") for (int d = 0; d < NDB; ++d) _Pragma("unroll") for (int r = 0; r < 16; ++r) o[d][r] *= al; \
            _Pragma("unroll") for (int r = 0; r < 16; ++r) { p0[r] -= dl; p1[r] -= dl; negm[r] = -m; } } } \
        float ls = 0.f; \
        _Pragma("unroll") for (int r = 0; r < 16; ++r) { const float e0 = __builtin_amdgcn_exp2f(p0[r]), e1 = __builtin_amdgcn_exp2f(p1[r]); p0[r] = e0; p1[r] = e1; ls += e0 + e1; } \
        l += ls; \
        _Pragma("unroll") for (int a = 0; a < 2; ++a) { \
            pw[a] = (v4u){cvtpk(p0[8 * a], p0[8 * a + 1]), cvtpk(p0[8 * a + 2], p0[8 * a + 3]), cvtpk(p0[8 * a + 4], p0[8 * a + 5]), cvtpk(p0[8 * a + 6], p0[8 * a + 7])}; \
            pw[2 + a] = (v4u){cvtpk(p1[8 * a], p1[8 * a + 1]), cvtpk(p1[8 * a + 2], p1[8 * a + 3]), cvtpk(p1[8 * a + 4], p1[8 * a + 5]), cvtpk(p1[8 * a + 6], p1[8 * a + 7])}; } \
        __builtin_amdgcn_s_setprio(0); } while (0)
#define FA_BAR() do { asm volatile("s_waitcnt lgkmcnt(0)" ::: "memory"); __builtin_amdgcn_s_barrier(); asm volatile("" ::: "memory"); } while (0)
#define FA_WAITV(n_) asm volatile("s_waitcnt vmcnt(%0)" :: "n"(n_) : "memory")
#define FA_EVEN(t_) do { FA_EVEN_WB(t_); FA_EVEN_ISSUE(t_); } while (0)
#define FA_ODD() do { } while (0)
#define FA_EVEN_WB(t_) do { if (SWA) { if ((t_) > 0) { if (more) FA_WAITV(2 * OPS); else FA_WAITV(0); } else if (blk == 0) FA_WAITV(0); else if (moreq) FA_WAITV(12); else FA_WAITV(8); }   \
        else { if ((t_) + 2 < nt) FA_WAITV(4 * OPS); else if ((t_) + 2 == nt) FA_WAITV(3 * OPS); else if ((t_) + 1 == nt) FA_WAITV(OPS); else FA_WAITV(0); } FA_BAR(); } while (0)
#define FA_EVEN_ISSUE(t_) do { if (SWA) { if ((t_) == 0 && more) { FA_ISSUE_K(t1, t1 & 3); FA_ISSUE_V(t1, t1 & 3); } } \
        else { if ((t_) + 3 < nt) FA_ISSUE_K(t0 + (t_) + 3, ((t_) + 3) & 3); if ((t_) + 2 < nt) FA_ISSUE_V(t0 + (t_) + 2, ((t_) + 2) & 3); } } while (0)
#define FA_KREAD(X, s0_) do { _Pragma("unroll") for (int s = 0; s < 2; ++s) { X[2 * s] = *(const LAS bf16x8*)(kp + koff[s + (s0_)]); X[2 * s + 1] = *(const LAS bf16x8*)(kp + koff[s + (s0_)] + 4096); } } while (0)
#define FA_QKA() do { p0 = __builtin_amdgcn_mfma_f32_32x32x16_bf16(ka[0], qr[0], negm, 0, 0, 0); p1 = __builtin_amdgcn_mfma_f32_32x32x16_bf16(ka[1], qr[0], negm, 0, 0, 0); \
        p0 = __builtin_amdgcn_mfma_f32_32x32x16_bf16(ka[2], qr[1], p0, 0, 0, 0); p1 = __builtin_amdgcn_mfma_f32_32x32x16_bf16(ka[3], qr[1], p1, 0, 0, 0); } while (0)
#define FA_QKB() do { p0 = __builtin_amdgcn_mfma_f32_32x32x16_bf16(kb[0], qr[2], p0, 0, 0, 0); p1 = __builtin_amdgcn_mfma_f32_32x32x16_bf16(kb[1], qr[2], p1, 0, 0, 0); \
        p0 = __builtin_amdgcn_mfma_f32_32x32x16_bf16(kb[2], qr[3], p0, 0, 0, 0); p1 = __builtin_amdgcn_mfma_f32_32x32x16_bf16(kb[3], qr[3], p1, 0, 0, 0); } while (0)
#define FA_PVQK(tpv_, tqk_, ISSUE_) do { const lds_cptr vp0 = vpl0 + FA_SLOT(tpv_) * VSL, vp1 = vpl1 + FA_SLOT(tpv_) * VSL; const lds_cptr kp = kpl + FA_SLOT(tqk_) * KSL; s16x4 val[4], vah[4], vbl[4], vbh[4]; bf16x8 ka[4], kb[4]; \
        FA_VREAD(va, 0); FA_SB(); FA_VREAD(vb, 1); FA_SB(); ISSUE_; FA_SB(); \
        if (NDB > 2) { FA_VMMA(va, 0); FA_SB(); FA_VREAD(va, 2); FA_SB(); FA_VMMA(vb, 1); FA_SB(); FA_VREAD(vb, 3); FA_SB(); FA_VMMA(va, 2); FA_SB(); FA_KREAD(ka, 0); FA_SB(); FA_VMMA(vb, 3); FA_SB(); FA_KREAD(kb, 2); FA_SB(); } \
        else { FA_KREAD(ka, 0); FA_SB(); FA_VMMA(va, 0); FA_SB(); FA_KREAD(kb, 2); FA_SB(); FA_VMMA(vb, 1); FA_SB(); } \
        FA_QKA(); FA_SB(); FA_QKB(); FA_SB(); } while (0)
    if constexpr (!SWA) {
#define FA_MASKMAX(i_) const int tg = t0 + (i_); \
        if (64 * tg + 63 > qrow0) { \
            _Pragma("unroll") for (int r = 0; r < 16; ++r) { const int kv = 64 * tg + crow(r, hi); p0[r] = (kv <= qg) ? p0[r] : -1e30f; p1[r] = (kv + 32 <= qg) ? p1[r] : -1e30f; } } \
        float mx = max3f(p0[0], p1[0], p0[1]); \
        mx = max3f(mx, p1[1], p0[2]); mx = max3f(mx, p1[2], p0[3]); mx = max3f(mx, p1[3], p0[4]); mx = max3f(mx, p1[4], p0[5]); mx = max3f(mx, p1[5], p0[6]); mx = max3f(mx, p1[6], p0[7]); \
        mx = max3f(mx, p1[7], p0[8]); mx = max3f(mx, p1[8], p0[9]); mx = max3f(mx, p1[9], p0[10]); mx = max3f(mx, p1[10], p0[11]); mx = max3f(mx, p1[11], p0[12]); mx = max3f(mx, p1[12], p0[13]); \
        mx = max3f(mx, p1[13], p0[14]); mx = max3f(mx, p1[14], p0[15]); mx = max3f(mx, p1[15], mx); \
        mx = xmax(mx); const bool rowvalid = mx > -1e29f;
#define FA_RESCALE() do { const float dl = rowvalid ? (unset ? mx : max3f(mx, 0.f, 0.f)) : 0.f; al_ = unset ? 1.f : __builtin_amdgcn_exp2f(-dl); \
            unset = unset && !rowvalid; m += dl; l *= al_; \
            _Pragma("unroll") for (int d = 0; d < NDB; ++d) _Pragma("unroll") for (int r = 0; r < 16; ++r) o[d][r] *= al_; \
            _Pragma("unroll") for (int r = 0; r < 16; ++r) { p0[r] -= dl; p1[r] -= dl; negm[r] = -m; } } while (0)
#define FA_EXPPACK() do { float ls = 0.f; \
        _Pragma("unroll") for (int r = 0; r < 16; ++r) { const float e0 = __builtin_amdgcn_exp2f(p0[r]), e1 = __builtin_amdgcn_exp2f(p1[r]); p0[r] = e0; p1[r] = e1; ls += e0 + e1; } \
        l += ls; \
        _Pragma("unroll") for (int a = 0; a < 2; ++a) { \
            pw[a] = (v4u){cvtpk(p0[8 * a], p0[8 * a + 1]), cvtpk(p0[8 * a + 2], p0[8 * a + 3]), cvtpk(p0[8 * a + 4], p0[8 * a + 5]), cvtpk(p0[8 * a + 6], p0[8 * a + 7])}; \
            pw[2 + a] = (v4u){cvtpk(p1[8 * a], p1[8 * a + 1]), cvtpk(p1[8 * a + 2], p1[8 * a + 3]), cvtpk(p1[8 * a + 4], p1[8 * a + 5]), cvtpk(p1[8 * a + 6], p1[8 * a + 7])}; } } while (0)
#define FA_VF(X, d_, ks_) do { const lds_cptr vq_ = (((d_) & 1) ? vp1 : vp0) + ((d_) >> 1) * 8192; X##l[d_] = vtr(vq_ + (ks_) * 2048); X##h[d_] = vtr(vq_ + (ks_) * 2048 + 1024); } while (0)
#define FA_PVM(X, d_, ks_) do { const bf16x8 va_ = (bf16x8){X##l[d_][0], X##l[d_][1], X##l[d_][2], X##l[d_][3], X##h[d_][0], X##h[d_][1], X##h[d_][2], X##h[d_][3]}; \
        o[d_] = __builtin_amdgcn_mfma_f32_32x32x16_bf16(va_, __builtin_bit_cast(bf16x8, pw[ks_]), o[d_], 0, 0, 0); } while (0)
#define FA_E0(r_) p0[r_] = __builtin_amdgcn_exp2f(p0[r_])
#define FA_E1(r_) p1[r_] = __builtin_amdgcn_exp2f(p1[r_])
#define FA_KF(X, j_) X[j_] = *(const LAS bf16x8*)(kp + koff[(j_) >> 1] + ((j_) & 1) * 4096)
#define FA_KG(X, j_) X[j_] = *(const LAS bf16x8*)(kp + koff[2 + ((j_) >> 1)] + ((j_) & 1) * 4096)
#define FA_FAST(tpv_, tqk_, DOQK_) do { const lds_cptr vp0 = vpl0 + FA_SLOT(tpv_) * VSL, vp1 = vpl1 + FA_SLOT(tpv_) * VSL; const lds_cptr kp = kpl + FA_SLOT(tqk_) * KSL; \
        s16x4 fal[4], fah[4], fbl[4], fbh[4]; bf16x8 ka[4], kb[4]; float ls = 0.f; \
        FA_VF(fa, 0, 0); FA_VF(fa, 1, 0); FA_VF(fa, 2, 0); FA_VF(fa, 3, 0); FA_VF(fb, 0, 1); FA_VF(fb, 1, 1); FA_VF(fb, 2, 1); FA_VF(fb, 3, 1); FA_SB(); \
        FA_PVM(fa, 0, 0); FA_E0(0); FA_E0(1); FA_SB(); \
        FA_PVM(fa, 1, 0); FA_E0(2); FA_E0(3); ls += p0[0] + p0[1]; FA_SB(); \
        FA_PVM(fa, 2, 0); FA_E0(4); FA_E0(5); ls += p0[2] + p0[3]; FA_SB(); \
        FA_PVM(fa, 3, 0); FA_E0(6); FA_E0(7); ls += p0[4] + p0[5]; FA_SB(); \
        FA_PVM(fb, 0, 1); FA_E0(8); FA_E0(9); ls += p0[6] + p0[7]; pw[0][0] = cvtpk(p0[0], p0[1]); FA_VF(fa, 0, 2); FA_SB(); \
        FA_PVM(fb, 1, 1); FA_E0(10); FA_E0(11); ls += p0[8] + p0[9]; pw[0][1] = cvtpk(p0[2], p0[3]); FA_VF(fa, 1, 2); FA_SB(); \
        FA_PVM(fb, 2, 1); FA_E0(12); FA_E0(13); ls += p0[10] + p0[11]; pw[0][2] = cvtpk(p0[4], p0[5]); FA_VF(fa, 2, 2); FA_SB(); \
        FA_PVM(fb, 3, 1); FA_E0(14); FA_E0(15); ls += p0[12] + p0[13]; pw[0][3] = cvtpk(p0[6], p0[7]); FA_VF(fa, 3, 2); FA_SB(); \
        FA_PVM(fa, 0, 2); FA_E1(0); FA_E1(1); ls += p0[14] + p0[15]; pw[1][0] = cvtpk(p0[8], p0[9]); FA_VF(fb, 0, 3); FA_SB(); \
        FA_PVM(fa, 1, 2); FA_E1(2); FA_E1(3); ls += p1[0] + p1[1]; pw[1][1] = cvtpk(p0[10], p0[11]); FA_VF(fb, 1, 3); FA_SB(); \
        FA_PVM(fa, 2, 2); FA_E1(4); FA_E1(5); ls += p1[2] + p1[3]; pw[1][2] = cvtpk(p0[12], p0[13]); FA_VF(fb, 2, 3); FA_SB(); \
        FA_PVM(fa, 3, 2); FA_E1(6); FA_E1(7); ls += p1[4] + p1[5]; pw[1][3] = cvtpk(p0[14], p0[15]); FA_VF(fb, 3, 3); FA_SB(); \
        FA_PVM(fb, 0, 3); FA_E1(8); FA_E1(9); ls += p1[6] + p1[7]; pw[2][0] = cvtpk(p1[0], p1[1]); if (DOQK_) FA_KF(ka, 0); FA_SB(); \
        FA_PVM(fb, 1, 3); FA_E1(10); FA_E1(11); ls += p1[8] + p1[9]; pw[2][1] = cvtpk(p1[2], p1[3]); if (DOQK_) FA_KF(ka, 1); FA_SB(); \
        FA_PVM(fb, 2, 3); FA_E1(12); FA_E1(13); ls += p1[10] + p1[11]; pw[2][2] = cvtpk(p1[4], p1[5]); if (DOQK_) FA_KF(ka, 2); FA_SB(); \
        FA_PVM(fb, 3, 3); FA_E1(14); FA_E1(15); ls += p1[12] + p1[13]; pw[2][3] = cvtpk(p1[6], p1[7]); if (DOQK_) FA_KF(ka, 3); FA_SB(); \
        ls += p1[14] + p1[15]; l += ls; pw[3] = (v4u){cvtpk(p1[8], p1[9]), cvtpk(p1[10], p1[11]), cvtpk(p1[12], p1[13]), cvtpk(p1[14], p1[15])}; FA_SB(); \
        if (DOQK_) { \
            p0 = __builtin_amdgcn_mfma_f32_32x32x16_bf16(ka[0], qr[0], negm, 0, 0, 0); FA_KG(kb, 0); FA_SB(); \
            p1 = __builtin_amdgcn_mfma_f32_32x32x16_bf16(ka[1], qr[0], negm, 0, 0, 0); FA_KG(kb, 1); FA_SB(); \
            p0 = __builtin_amdgcn_mfma_f32_32x32x16_bf16(ka[2], qr[1], p0, 0, 0, 0); FA_KG(kb, 2); FA_SB(); \
            p1 = __builtin_amdgcn_mfma_f32_32x32x16_bf16(ka[3], qr[1], p1, 0, 0, 0); FA_KG(kb, 3); FA_SB(); \
            p0 = __builtin_amdgcn_mfma_f32_32x32x16_bf16(kb[0], qr[2], p0, 0, 0, 0); p1 = __builtin_amdgcn_mfma_f32_32x32x16_bf16(kb[1], qr[2], p1, 0, 0, 0); \
            p0 = __builtin_amdgcn_mfma_f32_32x32x16_bf16(kb[2], qr[3], p0, 0, 0, 0); p1 = __builtin_amdgcn_mfma_f32_32x32x16_bf16(kb[3], qr[3], p1, 0, 0, 0); FA_SB(); } } while (0)
        if (!pref) { if (2 < nt) FA_WAITV(3 * OPS); else FA_WAITV(2 * OPS); }
        FA_BAR(); FA_QK(0);
        if (pref) FA_ISSUE_V(t0, 0);
#define FA_RESCALE_ALL() do { FA_RESCALE(); \
            _Pragma("unroll") for (int k = 0; k < 4; ++k) _Pragma("unroll") for (int j = 0; j < 4; ++j) { const unsigned w_ = pw[k][j]; pw[k][j] = cvtpk(bflo(w_) * al_, bfhi(w_) * al_); } } while (0)
#define FA_BLOCK_TOP(i_) \
            if ((i_) + 2 < nt) FA_WAITV(2 * OPS); else FA_WAITV(OPS);       \
            FA_BAR(); \
            if ((i_) + 3 < nt) FA_ISSUE_K(t0 + (i_) + 3, ((i_) + 3) & 3); \
            if ((i_) + 1 < nt) FA_ISSUE_V(t0 + (i_) + 1, ((i_) + 1) & 3); \
            FA_MASKMAX(i_)
        { FA_BLOCK_TOP(0) float al_; FA_RESCALE(); (void)al_; FA_EXPPACK(); FA_QK(1); }
#pragma unroll 1
        for (int i = 1; i < nt - 1; ++i) { FA_BLOCK_TOP(i) if (__any(mx > FA_THR)) { float al_; FA_RESCALE_ALL(); } FA_FAST(i - 1, i + 1, true); }
        const bool havenext = (blk + 1 < nblk); bool nk3 = false;
        { const int i = nt - 1; FA_BLOCK_TOP(i)
          if (havenext) {
              int nb_, nh_, nq_; FA_COORD(blk + 1, nb_, nh_, nq_); nk3 = (nq_ >> 6) + 2 > 2;
              const unsigned nks_ = (unsigned)(((size_t)nb_ * SEQ + krow) * NQKV + C_DK + nh_ * 128 + (((lane & 7) ^ ((krow >> 1) & 7)) * 8)) * 2u;
              FA_GLDS(nks_, wid * 1024); FA_GLDS(nks_ + 128u, 8192 + wid * 1024);
              FA_GLDS(nks_ + (64u * NQKV * 2u), KSL + wid * 1024); FA_GLDS(nks_ + 128u + (64u * NQKV * 2u), KSL + 8192 + wid * 1024);
              if (nk3) { FA_GLDS(nks_ + 2u * (64u * NQKV * 2u), 2 * KSL + wid * 1024); FA_GLDS(nks_ + 128u + 2u * (64u * NQKV * 2u), 2 * KSL + 8192 + wid * 1024); }
          }
          if (__any(mx > FA_THR)) { float al_; FA_RESCALE_ALL(); } FA_FAST(i - 1, i - 1, false); }
        if (havenext) { if (nk3) FA_WAITV(3 * OPS); else FA_WAITV(2 * OPS); } else FA_WAITV(0);
        FA_BAR(); FA_PV(nt - 1);
        { int nb_, nh_, nq_; FA_COORD(havenext ? blk + 1 : blk, nb_, nh_, nq_); const bf16* qp_ = FA_QPTR(nb_, nh_, nq_);
#pragma unroll
            for (int s = 0; s < 4; ++s) qn[s] = *(const bf16x8*)(qp_ + s * 16); }
#undef FA_RESCALE_ALL
#undef FA_BLOCK_TOP
#undef FA_MASKMAX
#undef FA_RESCALE
#undef FA_EXPPACK
#undef FA_VF
#undef FA_PVM
#undef FA_E0
#undef FA_E1
#undef FA_KF
#undef FA_KG
#undef FA_FAST
    } else {
    if (grp == 0) {
        FA_EVEN(0); FA_QK(0);
#pragma unroll 1
        for (int t = 0; t < nt - 1; ++t) { FA_ODD(); FA_SM(t); FA_EVEN_WB(t + 1); FA_PVQK(t, t + 1, FA_EVEN_ISSUE(t + 1)); }
        FA_ODD(); FA_SM(nt - 1); FA_EVEN(nt); FA_PV(nt - 1); FA_ODD();
    } else {
        FA_EVEN(0); FA_ODD(); FA_QK(0);
#pragma unroll 1
        for (int t = 0; t < nt - 1; ++t) { FA_EVEN(t + 1); FA_SM(t); FA_ODD(); FA_PVQK(t, t + 1, (void)0); }
        FA_EVEN(nt); FA_SM(nt - 1); FA_ODD(); FA_PV(nt - 1);
    }
    }
#undef FA_SB
#undef FA_SLOT
#undef FA_VREAD
#undef FA_VMMA
#undef FA_PV
#undef FA_QK
#undef FA_SM
#undef FA_EVEN
#undef FA_EVEN_WB
#undef FA_EVEN_ISSUE
#undef FA_KREAD
#undef FA_QKA
#undef FA_QKB
#undef FA_PVQK
#undef FA_WAITV
#undef FA_BAR
#undef FA_ODD
#undef FA_ISSUE_K
#undef FA_ISSUE_V
#undef FA_GLDS
#define FA_BAR2() do { asm volatile("s_waitcnt lgkmcnt(0)" ::: "memory"); __builtin_amdgcn_s_barrier(); asm volatile("" ::: "memory"); } while (0)
    if (moreq) { asm volatile("" : "+v"(qn[0]), "+v"(qn[1]), "+v"(qn[2]), "+v"(qn[3])); }
    float lt = xsum(l);
    if (SWA) lt += __builtin_amdgcn_exp2f(F.swa_sinks[hq] * LOG2E - m);
    const float inv = 1.f / lt;
    const size_t tok = (size_t)b * SEQ + qg;
    if (SWA) {
        bf16* op = F.ACT + tok * D + 512 + hq * 64;
#pragma unroll
        for (int d = 0; d < NDB; ++d)
#pragma unroll
            for (int g4 = 0; g4 < 4; ++g4) { const int dd = 32 * d + 8 * g4 + 4 * hi;
                v2u w; w.x = cvtpk(o[d][4 * g4] * inv, o[d][4 * g4 + 1] * inv); w.y = cvtpk(o[d][4 * g4 + 2] * inv, o[d][4 * g4 + 3] * inv);
                *(v2u*)(op + dd) = w; }
        if (!more) FA_BAR2();
    } else {
        LAS float* comb = (LAS float*)(L + 65536);
        FA_BAR2();
        if (sub == 1) {
#pragma unroll
            for (int d = 0; d < NDB; ++d)
#pragma unroll
                for (int r = 0; r < 16; ++r) comb[(rw * 64 + d * 16 + r) * 64 + lane] = o[d][r] * inv;
        }
        FA_BAR2();
        if (sub == 0) {
            int z_; asm volatile("v_mov_b32 %0, 0" : "=v"(z_));
            const LAS float* gd = (const LAS float*)(L + RING_BYTES + 1024 + z_);
            float ss = 0.f;
#pragma unroll
            for (int d = 0; d < NDB; ++d)
#pragma unroll
                for (int r = 0; r < 16; ++r) { const float v = o[d][r] * inv - lam * comb[(rw * 64 + d * 16 + r) * 64 + lane]; o[d][r] = v; ss += v * v; }
            ss = xsum(ss);
            const float rn = 0.8f / sqrtf(ss * (1.f / 128.f) + EPS);
            LAS unsigned char* tb = (LAS unsigned char*)(comb + rw * 64 * 64) + z_;
#pragma unroll
            for (int d = 0; d < NDB; ++d)
#pragma unroll
                for (int g4 = 0; g4 < 4; ++g4) { const int dd = 32 * d + 8 * g4 + 4 * hi; const f32x4 g = *(const LAS f32x4*)(gd + dd);
                    v2u w; w.x = cvtpk(o[d][4 * g4] * rn * g.x, o[d][4 * g4 + 1] * rn * g.y); w.y = cvtpk(o[d][4 * g4 + 2] * rn * g.z, o[d][4 * g4 + 3] * rn * g.w);
                    *(LAS v2u*)(tb + r32 * 272 + dd * 2) = w; }
            bf16* op = F.ACT + (tok - (size_t)r32) * D + hh * 128 + (lane & 15) * 8;
#pragma unroll 1
            for (int it = 0; it < 8; ++it) { const int row = 4 * it + (lane >> 4); *(v4u*)(op + (size_t)row * D) = *(const LAS v4u*)(tb + row * 272 + (lane & 15) * 16); }
        }
        FA_BAR2();
    }
  }
#undef FA_COORD
#undef FA_QPTR
}
#undef FA_BAR2
}

__device__ __forceinline__ void ph_attn(Frame& F) {
    const float lam = diff_lambda_value(F);
    if (F.tid < 128) ((LAS float*)(F.lds + RING_BYTES + 1024))[F.tid] = F.g_diff_sub[F.tid];
    __syncthreads();
    if (F.G == 256) fa::attn_unit<false>(F, 0, 0, 0, lam, 8);
    else {
#pragma unroll 1
        for (int u = F.bid; u < BATCH * 4 * 16; u += F.G) { const int pair = u >> 4, qb = u & 15; fa::attn_unit<false>(F, pair >> 2, pair & 3, qb * 128, lam, 1); }
    }
    if (F.G == 256) { const int j = F.bid >> 3; fa::attn_unit<true>(F, 4 * (F.bid & 7) + (j >> 3), (j >> 2) & 1, (j & 3) * 8 * 64, 0.f, 8); }
    else for (int u = F.bid * 8; u < BATCH * 2 * 32; u += F.G * 8) {
        const int qb = u & 31, kvh = (u >> 5) & 1, b = u >> 6;
        fa::attn_unit<true>(F, b, kvh, qb * 64, 0.f, 8);
    }
}

struct Args { const float* in[19]; float* out; unsigned char* ws; int ph_lo, ph_hi; };
__global__ void __launch_bounds__(NWAVES * 64, 2) mk_fwd(Args args) {
    extern __shared__ __attribute__((aligned(16))) unsigned char lds[];
    Frame F;
    F.lds = (LAS unsigned char*)lds;
    F.wave = __builtin_amdgcn_readfirstlane((int)threadIdx.x >> 6); F.lane = fresh_lane(); F.tid = F.wave * 64 + F.lane;
#define REFRESH_IDS() do { F.lane = fresh_lane(); F.tid = F.wave * 64 + F.lane; } while (0)
    F.G = gridDim.x; F.bid = blockIdx.x;
    unsigned char* ws = args.ws; F.ws = ws; F.ctl = (unsigned*)(ws + WS_CTL);
    F.x = args.in[0]; F.c = args.in[1]; F.w_ada = args.in[2]; F.b_ada = args.in[3]; F.g_mix = args.in[4]; F.w_in = args.in[5]; F.diff_lambda = args.in[6]; F.g_diff_sub = args.in[7];
    F.swa_sinks = args.in[8]; F.w_out = args.in[9]; F.g_ffn = args.in[10]; F.w_rg = args.in[11]; F.b_rg = args.in[12]; F.w_re = args.in[13]; F.b_re = args.in[14];
    F.w_gate = args.in[15]; F.w_up = args.in[16]; F.w_down = args.in[17]; F.g_final = args.in[18]; F.out = args.out;
    F.mod = (float*)(ws + WS_MOD); F.rope = (float*)(ws + WS_ROPE);
    F.tok_e = (int*)(ws + WS_TOK); F.tok_r0 = F.tok_e + T; F.tok_r1 = F.tok_e + 2 * T; F.tok_w0 = (float*)(F.tok_e + 3 * T); F.tok_w1 = (float*)(F.tok_e + 4 * T);
    F.list = (int*)(ws + WS_LIST);
    F.WinT = (bf16*)(ws + WS_WIN); F.WoT = (bf16*)(ws + WS_WO); F.WguT = ws + WS_WGU; F.WdT = ws + WS_WD;
    F.ACT = (bf16*)(ws + WS_ACT); F.QKV = (bf16*)(ws + WS_QKV); F.Y = ws + WS_QKV;
    F.X1 = (bf16*)(ws + WS_GU); F.ACTM = ws + WS_ACTM; F.H8 = ws + 612 * MiB;
    for (int u = F.tid; u < (LDS_BYTES - RING_BYTES) / 4; u += NWAVES * 64) ((LAS unsigned*)(F.lds + RING_BYTES))[u] = 0u;
    __syncthreads();
    XcdBarrier bar; bar.bar = (unsigned*)(F.ctl + CW_BAR); bar.x = 0; bar.st = nullptr;
#if MK_ONE_LAUNCH
    bar = xcd_barrier_post((unsigned*)(F.ctl + CW_BAR), (volatile LAS unsigned*)(F.lds + MISC_OFF));
    if (F.tid == 0) {
        const unsigned g1 = (unsigned)(F.bid & 7) + 1u, x1 = bar.x + 1u;
        const unsigned o1 = atomicCAS(F.ctl + CW_GMAP + bar.x, 0u, g1), o2 = atomicCAS(F.ctl + CW_GMAP + 16 + (F.bid & 7), 0u, x1);
        if ((o1 != 0u && o1 != g1) || (o2 != 0u && o2 != x1)) (void)xb_add(F.ctl + CW_GMAP + 24, 1u);
    }
#endif
    bool grp_ok = false;
    const int lo = args.ph_lo, hi = args.ph_hi;
#define IN(k) (lo <= (k) && (k) < hi)
#if MK_ONE_LAUNCH
#define SEAM(k) do { if (IN(k) && IN((k) + 1)) { if ((k) >= 1 && (k) <= 4 && grp_ok) group_barrier(F.ctl, bar.bar, (k), F.bid & 7); else xcd_barrier(bar); \
        if ((k) == 0) grp_ok = (F.G == 256) && __builtin_amdgcn_readfirstlane((int)xb_ld(F.ctl + CW_GMAP + 24)) == 0; } } while (0)
#else
#define SEAM(k) do { } while (0)
#endif
    if (IN(0)) { REFRESH_IDS(); ph_prologue(F); SEAM(0); }
    if (IN(1)) { REFRESH_IDS(); ph_norm1(F); SEAM(1); }
    if (IN(2)) {
        pg8::Gemm g{F.ACT, F.WinT, T, NQKV, D, 0}; pg8::StaticOrder S; S.init(T, NQKV, F.G, F.bid);
        pg8::EpiRope E{F.QKV, NQKV, F.rope};
        pg8::gemm_phase<pg8::EpiRope, pg8::StaticOrder, true, true>(F.lds, g, S, E, F.wave);
        SEAM(2);
    }
    if (IN(3)) { REFRESH_IDS(); ph_attn(F); SEAM(3); }
    if (IN(4)) {
        REFRESH_IDS();
        const int kall = (12288 + F.G * NWAVES - 1) / (F.G * NWAVES), kpre = ((((F.bid >> 3) & 7) % 3) * kall) / 2;
        expert_items(F, 0, kpre);
        __syncthreads();
        {
            pg8::Gemm g{F.ACT, F.WoT, T, D, D, 0}; pg8::StaticOrder S; S.init(T, D, F.G, F.bid);
            pg8::EpiResid E{F.x, F.X1, F.mod};
            pg8::gemm_phase<pg8::EpiResid, pg8::StaticOrder, true, true>(F.lds, g, S, E, F.wave);
        }
        REFRESH_IDS();
        expert_items(F, kpre, kall);
        SEAM(4);
    }
    if (IN(5)) { REFRESH_IDS(); ph_norm2_route(F); SEAM(5); }
    if (IN(6)) { REFRESH_IDS();
        LAS int* ts = (LAS int*)(F.lds + RING_BYTES); load_tstart(F, ts);
        pg8::Gemm g{(const bf16*)F.H8, (const bf16*)F.WguT, T, 1024, D / 2, (size_t)1024 * 1024}; pg8::MoeOrder S{4, F.G, F.bid, __builtin_amdgcn_readfirstlane(ts[16]), (const PG8_LAS int*)ts};
        LAS unsigned* gath = (LAS unsigned*)(F.lds + RING_BYTES + 2048);
        for (int i = 0; i < 9; ++i) { pg8::Unit u; if (!S.next(i, u)) break;
            if (F.tid < 256) { const int rk = (u.pm - ts[u.e]) * 256 + F.tid, n = ts[32 + u.e];
                const unsigned tok = __hip_atomic_load((unsigned*)F.list + (size_t)u.e * T + (rk < n ? rk : 0), RLX_AGENT); gath[i * 256 + F.tid] = tok * 1024u; } }
        __syncthreads();
        pg8::EpiSwiGLU E{F.ACTM};
        pg8::gemm_phase<pg8::EpiSwiGLU, pg8::MoeOrder, true, true, true, true>(F.lds, g, S, E, F.wave, (const PG8_LAS unsigned*)gath);
        SEAM(6);
    }
    if (IN(7)) { REFRESH_IDS();
        LAS int* ts = (LAS int*)(F.lds + RING_BYTES); load_tstart(F, ts);
        pg8::Gemm g{(const bf16*)F.ACTM, (const bf16*)F.WdT, SORT_ROWS, 1024, DEXP / 2, (size_t)1024 * 512}; pg8::MoeOrder S{4, F.G, F.bid, __builtin_amdgcn_readfirstlane(ts[16]), (const PG8_LAS int*)ts};
        pg8::EpiPlain8 E{F.Y, 1024};
        pg8::gemm_phase<pg8::EpiPlain8, pg8::MoeOrder, true, true, false, true>(F.lds, g, S, E, F.wave);
        SEAM(7);
    }
    if (IN(8)) { REFRESH_IDS(); ph_final(F); }
#undef IN
#undef SEAM
}

extern "C" void kernel_launch(void* const* d_in, const int* in_sizes, int n_in, void* d_out, int out_size, void* d_ws, size_t ws_size, hipStream_t stream) {
    static int grid = 0;
    if (grid == 0) {
        if (n_in != 19 || in_sizes[0] != T * D || out_size != T * D || ws_size < WS_END) { fprintf(stderr, "kernel_launch: unexpected shapes/workspace: n_in %d in0 %d out %d ws %zu (need %zu); nothing launched\n", n_in, n_in > 0 ? in_sizes[0] : -1, out_size, ws_size, (size_t)WS_END); grid = -1; return; }
        int dev = 0, cus = 0, per_cu = 0;
        if (hipGetDevice(&dev) != hipSuccess || hipDeviceGetAttribute(&cus, hipDeviceAttributeMultiprocessorCount, dev) != hipSuccess) { fprintf(stderr, "kernel_launch: device query failed\n"); grid = -1; return; }
        if (hipFuncSetAttribute((const void*)mk_fwd, hipFuncAttributeMaxDynamicSharedMemorySize, LDS_BYTES) != hipSuccess) { fprintf(stderr, "kernel_launch: hipFuncSetAttribute failed\n"); grid = -1; return; }
        if (hipOccupancyMaxActiveBlocksPerMultiprocessor(&per_cu, (const void*)mk_fwd, NWAVES * 64, LDS_BYTES) != hipSuccess || per_cu < 1)
            fprintf(stderr, "kernel_launch: note: occupancy query reports %d workgroups per CU\n", per_cu);
        (void)hipGetLastError();
        grid = cus;
    }
    if (grid < 0) return;
    if (hipMemsetAsync((char*)d_ws + WS_CTL, 0, CTL_ZERO_BYTES, stream) != hipSuccess) { fprintf(stderr, "kernel_launch: memset failed\n"); return; }
    Args a{};
    for (int i = 0; i < 19; ++i) a.in[i] = (const float*)d_in[i];
    a.out = (float*)d_out; a.ws = (unsigned char*)d_ws;
#if MK_ONE_LAUNCH
    a.ph_lo = 0; a.ph_hi = N_PHASES;
    hipLaunchKernelGGL(mk_fwd, dim3(grid), dim3(NWAVES * 64), LDS_BYTES, stream, a);
#else
    for (int p = 0; p < N_PHASES; ++p) { a.ph_lo = p; a.ph_hi = p + 1; hipLaunchKernelGGL(mk_fwd, dim3(grid), dim3(NWAVES * 64), LDS_BYTES, stream, a); }
#endif
    const hipError_t le = hipPeekAtLastError();
    if (le != hipSuccess) fprintf(stderr, "kernel_launch: launch failed: %s\n", hipGetErrorName(le));
}
```
